# Optimizing an MI355X kernel written in HIP

```python
import math
import jax
import jax.numpy as jnp
from jax import lax
import numpy as np

D_MODEL = 1024
BATCH = 2
SEQ = 8192
DEPTH = 4

GRID_W = 64
CTX_LEN = 256

HEAD_DIM = 64
ATTN_HEADS = 8
ATTN_KV_HEADS = 2
ATTN_GROUP = ATTN_HEADS // ATTN_KV_HEADS
ATTN_WIDTH = ATTN_HEADS * HEAD_DIM
KV_WIDTH = ATTN_KV_HEADS * HEAD_DIM
ATTN_SCALE = HEAD_DIM ** -0.5
Q_BLOCK = 128
ROPE_THETA = 10000.0

HYENA_WIDTH = 256
HYENA_ORDER = 2
SHORT_CONV = 3
FILTER_BANDS = 16
FILTER_EMB = 1 + 2 * FILTER_BANDS
FILTER_HIDDEN = 64
HYENA_TARGET = 1e-2
HYENA_FAST_DECAY_PCT = 0.3
HYENA_SLOW_DECAY_PCT = 1.5
HYENA_MIN_DECAY = math.log(HYENA_TARGET) / HYENA_SLOW_DECAY_PCT
HYENA_MAX_DECAY = math.log(HYENA_TARGET) / HYENA_FAST_DECAY_PCT

GLA_HEADS = 4
GLA_DK = 32
GLA_DV = 64
GLA_K_WIDTH = GLA_HEADS * GLA_DK
GLA_V_WIDTH = GLA_HEADS * GLA_DV
GLA_GATE_RANK = 16
GLA_GATE_TAU = 16.0
GLA_CHUNK = 64

MIX_WIDTH = ATTN_WIDTH + HYENA_WIDTH + GLA_V_WIDTH
FFN_HIDDEN = -(-8 * D_MODEL // (3 * 256)) * 256
N_MOD = 6
NORM_EPS = 1e-6

IN_SPLITS = (ATTN_WIDTH, KV_WIDTH, KV_WIDTH, 3 * HYENA_WIDTH, GLA_K_WIDTH, GLA_K_WIDTH,
             GLA_V_WIDTH, GLA_V_WIDTH, GLA_GATE_RANK, GLA_GATE_RANK)
IN_WIDTH = sum(IN_SPLITS)

kernel_name = "hybrid_gqa_hyena_gla_prefix_dit"


def rms_norm(x, g):
    xf = x.astype(jnp.float32)
    y = xf * lax.rsqrt(jnp.mean(jnp.square(xf), axis=-1, keepdims=True) + NORM_EPS)
    return (y * g.astype(jnp.float32)).astype(x.dtype)


def head_rms_norm(x, g):
    shp = x.shape
    xh = x.reshape(shp[:-1] + (shp[-1] // HEAD_DIM, HEAD_DIM))
    return rms_norm(xh, g.reshape(-1, HEAD_DIM)).reshape(shp)


def modulate(x, shift, scale):
    return x * (1.0 + scale) + shift


def split_columns(p):
    parts, start = [], 0
    for width in IN_SPLITS:
        parts.append(p[..., start:start + width])
        start += width
    return parts


def axial_rope_tables(n_tokens):
    rows = n_tokens // GRID_W
    row = jnp.broadcast_to(jnp.arange(rows, dtype=jnp.float32)[:, None], (rows, GRID_W)).reshape(-1)
    col = jnp.broadcast_to(jnp.arange(GRID_W, dtype=jnp.float32)[None, :], (rows, GRID_W)).reshape(-1)
    n_freq = HEAD_DIM // 4
    inv_freq = jnp.power(ROPE_THETA, -jnp.arange(n_freq, dtype=jnp.float32) / n_freq)
    ang = jnp.concatenate([row[:, None] * inv_freq, col[:, None] * inv_freq], axis=-1)
    return jnp.cos(ang), jnp.sin(ang)


def apply_rope(x, cos, sin):
    half = HEAD_DIM // 2
    xf = x.astype(jnp.float32)
    x1, x2 = xf[..., :half], xf[..., half:]
    c, s = cos[None, :, None, :], sin[None, :, None, :]
    return jnp.concatenate([x1 * c - x2 * s, x1 * s + x2 * c], axis=-1).astype(x.dtype)


def gqa_attend(q, k, v):
    b, lq = q.shape[:2]
    qg = q.reshape(b, lq, ATTN_KV_HEADS, ATTN_GROUP, HEAD_DIM)
    s = jnp.einsum('bqkgd,bskd->bkgqs', qg, k, preferred_element_type=jnp.float32)
    p = jax.nn.softmax(s, axis=-1).astype(v.dtype)
    o = jnp.einsum('bkgqs,bskd->bqkgd', p, v)
    return o.reshape(b, lq, ATTN_WIDTH)


def latent_block_attention(q_lat, k_all, v_all):
    b, n = q_lat.shape[:2]
    nb = n // Q_BLOCK
    qb = q_lat.reshape(b, nb, Q_BLOCK, ATTN_HEADS, HEAD_DIM).swapaxes(0, 1)
    ob = lax.map(lambda blk: gqa_attend(blk, k_all, v_all), qb)
    return ob.swapaxes(0, 1).reshape(b, n, ATTN_WIDTH)


def short_conv(u, w, b):
    pad = SHORT_CONV // 2
    y = lax.conv_general_dilated(u, w[:, None, :].astype(u.dtype), window_strides=(1,), padding=[(pad, pad)],
                                 dimension_numbers=('NWC', 'WIO', 'NWC'), feature_group_count=u.shape[-1])
    return y + b


def hyena_filter_spectra(n, w1, b1, w2, b2, w3, freq):
    f32 = jnp.float32
    t = jnp.linspace(0.0, 1.0, n, dtype=f32)[:, None]
    omega = (2.0 * math.pi / n) * jnp.arange(n, dtype=f32)
    bands = jnp.linspace(1e-4, FILTER_BANDS - 1, FILTER_BANDS, dtype=f32)
    phase = omega[:, None] * bands[None, :]
    z = jnp.concatenate([t, jnp.cos(phase), -jnp.sin(phase)], axis=-1)
    fr = freq.astype(f32)
    h = jnp.sin(fr * (z @ w1.astype(f32) + b1.astype(f32)))
    h = jnp.sin(fr * (h @ w2.astype(f32) + b2.astype(f32)))
    h = (h @ w3.astype(f32)).reshape(n, HYENA_ORDER, 2, HYENA_WIDTH)
    deltas = jnp.abs(jnp.linspace(HYENA_MIN_DECAY, HYENA_MAX_DECAY, HYENA_WIDTH, dtype=f32))
    window = jnp.exp(-t * deltas[None, :])
    h = h * window[:, None, None, :]
    h_pos, h_neg = h[:, :, 0], h[:, :, 1]
    h_circ = jnp.concatenate([h_pos, jnp.zeros((1, HYENA_ORDER, HYENA_WIDTH), f32), h_neg[:0:-1]], axis=0)
    return jnp.fft.rfft(h_circ, axis=0)


def long_conv(z, spec, bias):
    n = z.shape[1]
    y = jnp.fft.irfft(jnp.fft.rfft(z, n=2 * n, axis=1) * spec[None], n=2 * n, axis=1)[:, :n]
    return y + z * bias


def hyena_mix(proj, conv_w, conv_b, spec, bias):
    u = short_conv(proj, conv_w, conv_b).astype(jnp.float32)
    v, x1, x2 = u[..., :HYENA_WIDTH], u[..., HYENA_WIDTH:2 * HYENA_WIDTH], u[..., 2 * HYENA_WIDTH:]
    bias = bias.astype(jnp.float32)
    z = x1 * long_conv(v, spec[:, 0], bias[0])
    z = x2 * long_conv(z, spec[:, 1], bias[1])
    return z.astype(proj.dtype)


def gla_chunked(q, k, v, log_a, s0):
    b, n, h, _ = q.shape
    dv = v.shape[-1]
    nc = n // GLA_CHUNK

    def to_chunks(t):
        return t.reshape(b, nc, GLA_CHUNK, h, t.shape[-1]).transpose(0, 1, 3, 2, 4)

    qc, kc, vc, gc = to_chunks(q), to_chunks(k), to_chunks(v), to_chunks(log_a)
    g_cum = jnp.cumsum(gc, axis=3)
    g_last = g_cum[:, :, :, -1:, :]
    q_dec = qc * jnp.exp(g_cum)
    k_dec = kc * jnp.exp(-g_cum)
    k_tail = kc * jnp.exp(g_last - g_cum)
    lower = jnp.tril(jnp.ones((GLA_CHUNK, GLA_CHUNK), dtype=bool))
    scores = jnp.where(lower, jnp.einsum('bnhid,bnhjd->bnhij', q_dec, k_dec), 0.0)
    o_intra = jnp.einsum('bnhij,bnhjv->bnhiv', scores, vc)
    kv = jnp.einsum('bnhjd,bnhjv->bnhdv', k_tail, vc)
    decay = jnp.exp(g_last[:, :, :, 0, :])

    def step(state, inp):
        d, kv_c = inp
        return d[..., None] * state + kv_c, state

    s_final, s_prev = lax.scan(step, s0, (jnp.moveaxis(decay, 1, 0), jnp.moveaxis(kv, 1, 0)))
    s_prev = jnp.moveaxis(s_prev, 0, 1)
    o_inter = jnp.einsum('bnhid,bnhdv->bnhiv', q_dec, s_prev)
    o = (o_intra + o_inter).transpose(0, 1, 3, 2, 4).reshape(b, n, h, dv)
    return o, s_final


def gla_bidirectional(q_l, k_l, v_l, af_l, ab_l, q_c, k_c, v_c, af_c, ab_c):
    b = q_l.shape[0]
    s0 = jnp.zeros((b, GLA_HEADS, GLA_DK, GLA_DV), jnp.float32)
    rev = lambda t: t[:, ::-1]
    oc_f, sc_f = gla_chunked(q_c, k_c, v_c, af_c, s0)
    oc_b, sc_b = gla_chunked(rev(q_c), rev(k_c), rev(v_c), rev(ab_c), s0)
    ol_f, _ = gla_chunked(q_l, k_l, v_l, af_l, sc_f)
    ol_b, _ = gla_chunked(rev(q_l), rev(k_l), rev(v_l), rev(ab_l), sc_b)
    return ol_f + rev(ol_b), oc_f + rev(oc_b)


def mixer_inputs(u, w_in, q_norm_g, k_norm_g, gla_gate_w, gla_gate_b):
    b, n = u.shape[:2]
    f32 = jnp.float32
    aq, ak, av, hy, gq, gk, gv, gr, gaf, gab = split_columns(u @ w_in)
    q = rms_norm(aq.reshape(b, n, ATTN_HEADS, HEAD_DIM), q_norm_g)
    k = rms_norm(ak.reshape(b, n, ATTN_KV_HEADS, HEAD_DIM), k_norm_g)
    v = av.reshape(b, n, ATTN_KV_HEADS, HEAD_DIM)
    gla_q = gq.reshape(b, n, GLA_HEADS, GLA_DK).astype(f32) * (GLA_DK ** -0.5)
    gla_k = gk.reshape(b, n, GLA_HEADS, GLA_DK).astype(f32)
    gla_v = gv.reshape(b, n, GLA_HEADS, GLA_DV).astype(f32)

    def log_gate(low_rank, d):
        zg = (low_rank @ gla_gate_w[d] + gla_gate_b[d]).astype(f32)
        return (jax.nn.log_sigmoid(zg) / GLA_GATE_TAU).reshape(b, n, GLA_HEADS, GLA_DK)

    gla = (gla_q, gla_k, gla_v, log_gate(gaf, 0), log_gate(gab, 1))
    return q, k, v, hy, gla, gr


def merge_heads(attn_o, hy_o, gla_o, gate_r, out_norm_g, w_out):
    dt = attn_o.dtype
    gla_flat = gla_o.reshape(gla_o.shape[:2] + (GLA_V_WIDTH,))
    y = jnp.concatenate([
        head_rms_norm(attn_o, out_norm_g[:ATTN_WIDTH]),
        head_rms_norm(hy_o, out_norm_g[ATTN_WIDTH:ATTN_WIDTH + HYENA_WIDTH]),
        (head_rms_norm(gla_flat, out_norm_g[ATTN_WIDTH + HYENA_WIDTH:]) * jax.nn.silu(gate_r.astype(jnp.float32))).astype(dt),
    ], axis=-1)
    return y @ w_out


def swiglu(u, w1, w3, w2):
    return (jax.nn.silu(u @ w1) * (u @ w3)) @ w2


def hybrid_layer(h_lat, h_ctx, mod_lat, mod_ctx, rope_cos, rope_sin, norm1_g, w_in, q_norm_g, k_norm_g,
                 hy_conv_w, hy_conv_b, filt_w1, filt_b1, filt_w2, filt_b2, filt_w3, filt_freq, hy_bias,
                 gla_gate_w, gla_gate_b, out_norm_g, w_out, norm2_g, ffn_w1, ffn_w3, ffn_w2, update_ctx):
    n_lat, n_ctx = h_lat.shape[1], h_ctx.shape[1]
    sh1_l, sc1_l, g1_l, sh2_l, sc2_l, g2_l = jnp.split(mod_lat, N_MOD, axis=-1)
    sh1_c, sc1_c, g1_c, sh2_c, sc2_c, g2_c = jnp.split(mod_ctx, N_MOD, axis=-1)
    u_lat = modulate(rms_norm(h_lat, norm1_g), sh1_l, sc1_l)
    u_ctx = modulate(rms_norm(h_ctx, norm1_g), sh1_c, sc1_c)
    q_l, k_l, v_l, hy_l, gla_l, r_l = mixer_inputs(u_lat, w_in, q_norm_g, k_norm_g, gla_gate_w, gla_gate_b)
    q_c, k_c, v_c, hy_c, gla_c, r_c = mixer_inputs(u_ctx, w_in, q_norm_g, k_norm_g, gla_gate_w, gla_gate_b)

    q_l = apply_rope(q_l, rope_cos, rope_sin) * ATTN_SCALE
    k_l = apply_rope(k_l, rope_cos, rope_sin)
    q_c = q_c * ATTN_SCALE
    attn_l = latent_block_attention(q_l, jnp.concatenate([k_l, k_c], axis=1), jnp.concatenate([v_l, v_c], axis=1))

    filt = (filt_w1, filt_b1, filt_w2, filt_b2, filt_w3, filt_freq)
    hy_out_l = hyena_mix(hy_l, hy_conv_w, hy_conv_b, hyena_filter_spectra(n_lat, *filt), hy_bias)

    gla_out_l, gla_out_c = gla_bidirectional(*gla_l, *gla_c)

    h_lat = h_lat + g1_l * merge_heads(attn_l, hy_out_l, gla_out_l, r_l, out_norm_g, w_out)
    h_lat = h_lat + g2_l * swiglu(modulate(rms_norm(h_lat, norm2_g), sh2_l, sc2_l), ffn_w1, ffn_w3, ffn_w2)

    if update_ctx:
        attn_c = gqa_attend(q_c, k_c, v_c)
        hy_out_c = hyena_mix(hy_c, hy_conv_w, hy_conv_b, hyena_filter_spectra(n_ctx, *filt), hy_bias)
        h_ctx = h_ctx + g1_c * merge_heads(attn_c, hy_out_c, gla_out_c, r_c, out_norm_g, w_out)
        h_ctx = h_ctx + g2_c * swiglu(modulate(rms_norm(h_ctx, norm2_g), sh2_c, sc2_c), ffn_w1, ffn_w3, ffn_w2)
    return h_lat, h_ctx


def setup_inputs(seed: int = 0) -> dict:
    key = jax.random.key(seed)
    ks = jax.random.split(key, 28)
    f32 = jnp.float32

    def nrm(k, shape, std):
        return std * jax.random.normal(k, shape, f32)

    d = D_MODEL
    return {
        "x": nrm(ks[0], (BATCH, SEQ, d), 1.0),
        "c": nrm(ks[1], (BATCH, d), 1.0),
        "ctx": nrm(ks[2], (BATCH, CTX_LEN, d), 1.0),
        "c_ctx": nrm(ks[3], (d,), 1.0),
        "ada_w": nrm(ks[4], (DEPTH, d, N_MOD * d), 0.5 * d ** -0.5),
        "ada_b": nrm(ks[5], (DEPTH, N_MOD * d), 0.02),
        "norm1_g": 1.0 + nrm(ks[6], (DEPTH, d), 0.02),
        "w_in": nrm(ks[7], (DEPTH, d, IN_WIDTH), d ** -0.5),
        "q_norm_g": 1.0 + nrm(ks[8], (DEPTH, HEAD_DIM), 0.02),
        "k_norm_g": 1.0 + nrm(ks[9], (DEPTH, HEAD_DIM), 0.02),
        "hy_conv_w": nrm(ks[10], (DEPTH, SHORT_CONV, 3 * HYENA_WIDTH), SHORT_CONV ** -0.5),
        "hy_conv_b": nrm(ks[11], (DEPTH, 3 * HYENA_WIDTH), 0.02),
        "filt_w1": nrm(ks[12], (DEPTH, FILTER_EMB, FILTER_HIDDEN), FILTER_EMB ** -0.5),
        "filt_b1": nrm(ks[13], (DEPTH, FILTER_HIDDEN), 0.02),
        "filt_w2": nrm(ks[14], (DEPTH, FILTER_HIDDEN, FILTER_HIDDEN), FILTER_HIDDEN ** -0.5),
        "filt_b2": nrm(ks[15], (DEPTH, FILTER_HIDDEN), 0.02),
        "filt_w3": nrm(ks[16], (DEPTH, FILTER_HIDDEN, HYENA_ORDER * 2 * HYENA_WIDTH), 0.02),
        "filt_freq": 1.0 + nrm(ks[17], (DEPTH, FILTER_HIDDEN), 0.02),
        "hy_bias": nrm(ks[18], (DEPTH, HYENA_ORDER, HYENA_WIDTH), 0.5),
        "gla_gate_w": nrm(ks[19], (DEPTH, 2, GLA_GATE_RANK, GLA_K_WIDTH), GLA_GATE_RANK ** -0.5),
        "gla_gate_b": nrm(ks[20], (DEPTH, 2, GLA_K_WIDTH), 0.02),
        "out_norm_g": 1.0 + nrm(ks[21], (DEPTH, MIX_WIDTH), 0.02),
        "w_out": nrm(ks[22], (DEPTH, MIX_WIDTH, d), MIX_WIDTH ** -0.5),
        "norm2_g": 1.0 + nrm(ks[23], (DEPTH, d), 0.02),
        "ffn_w1": nrm(ks[24], (DEPTH, d, FFN_HIDDEN), d ** -0.5),
        "ffn_w3": nrm(ks[25], (DEPTH, d, FFN_HIDDEN), d ** -0.5),
        "ffn_w2": nrm(ks[26], (DEPTH, FFN_HIDDEN, d), FFN_HIDDEN ** -0.5),
        "final_norm_g": 1.0 + nrm(ks[27], (d,), 0.02),
    }


def reference(x, c, ctx, c_ctx, ada_w, ada_b, norm1_g, w_in, q_norm_g, k_norm_g, hy_conv_w, hy_conv_b,
              filt_w1, filt_b1, filt_w2, filt_b2, filt_w3, filt_freq, hy_bias, gla_gate_w, gla_gate_b,
              out_norm_g, w_out, norm2_g, ffn_w1, ffn_w3, ffn_w2, final_norm_g):
    rope_cos, rope_sin = axial_rope_tables(x.shape[1])
    silu_c = jax.nn.silu(c)
    silu_cc = jax.nn.silu(c_ctx)
    h_lat, h_ctx = x, ctx
    for i in range(DEPTH):
        mod_lat = (silu_c @ ada_w[i] + ada_b[i])[:, None, :]
        mod_ctx = (silu_cc @ ada_w[i] + ada_b[i])[None, None, :]
        h_lat, h_ctx = hybrid_layer(
            h_lat, h_ctx, mod_lat, mod_ctx, rope_cos, rope_sin, norm1_g[i], w_in[i], q_norm_g[i], k_norm_g[i],
            hy_conv_w[i], hy_conv_b[i], filt_w1[i], filt_b1[i], filt_w2[i], filt_b2[i], filt_w3[i], filt_freq[i],
            hy_bias[i], gla_gate_w[i], gla_gate_b[i], out_norm_g[i], w_out[i], norm2_g[i],
            ffn_w1[i], ffn_w3[i], ffn_w2[i], i < DEPTH - 1)
    return rms_norm(h_lat, final_norm_g)
```

```cpp
#include <hip/hip_runtime.h>
#include <hip/hip_cooperative_groups.h>
#include <cstdio>
namespace cg = cooperative_groups;

typedef unsigned short bf16_t;
typedef short bf16x8 __attribute__((ext_vector_type(8)));
typedef short s16x4 __attribute__((ext_vector_type(4)));
typedef float f32x4 __attribute__((ext_vector_type(4)));
typedef float f32x16 __attribute__((ext_vector_type(16)));
typedef unsigned u32x4 __attribute__((ext_vector_type(4)));
typedef unsigned u32x2 __attribute__((ext_vector_type(2)));

#define NT 512
#ifndef PH
#define PH 0xffff
#endif
#define LDS_BYTES 143360
#define TOK 16896
#define DM 1024
#define NKEY 8448
#define FFH 2816
#define EPS 1e-6f

#define OFF_CNT 0ULL
#define OFF_MOD 4096ULL
#define OFF_ROPE 299008ULL
#define OFF_H2L 2396160ULL
#define OFF_H2C 10784768ULL
#define OFF_HC 11046912ULL
#define OFF_HRES 12095488ULL
#define OFF_U 81301504ULL
#define OFF_Q 115904512ULL
#define OFF_K 133206016ULL
#define OFF_VT 137531392ULL
#define OFF_WIN 141856768ULL
#define OFF_WOUT 146837504ULL
#define OFF_W13 148934656ULL
#define OFF_W2 160468992ULL
#define OFF_SPEC 166236160ULL
#define OFF_HYP 199794688ULL
#define OFF_GQ 225746944ULL
#define OFF_GK 234397696ULL
#define OFF_GV 243048448ULL
#define OFF_GR 260349952ULL
#define OFF_LGF 277651456ULL
#define OFF_LGB 286302208ULL
#define OFF_HYRAW 294952960ULL
#define OFF_KV 312254464ULL
#define OFF_DEC 329555968ULL
#define OFF_HMID 199794688ULL
#define WS_NEED 329826304ULL

struct Params {
  const float *x, *c, *ctx, *c_ctx, *ada_w, *ada_b, *norm1_g, *w_in, *q_norm_g, *k_norm_g, *hy_conv_w, *hy_conv_b,
      *filt_w1, *filt_b1, *filt_w2, *filt_b2, *filt_w3, *filt_freq, *hy_bias, *gla_gate_w, *gla_gate_b, *out_norm_g,
      *w_out, *norm2_g, *ffn_w1, *ffn_w3, *ffn_w2, *final_norm_g;
  float* out;
  unsigned char* ws;
};

#define DI __device__ __forceinline__
DI bf16_t f2bf(float x) { unsigned u = __float_as_uint(x); u += 0x7fffu + ((u >> 16) & 1u); return (bf16_t)(u >> 16); }
DI unsigned pk2(float a, float b) { return (unsigned)f2bf(a) | ((unsigned)f2bf(b) << 16); }
DI float bf2f(bf16_t v) { return __uint_as_float(((unsigned)v) << 16); }
DI float wave_sum(float v) {
#pragma unroll
  for (int o = 1; o < 64; o <<= 1) v += __shfl_xor(v, o);
  return v;
}
DI float siluf(float x) { return x / (1.f + __expf(-x)); }
DI int row_mod(int row) { return row < 8192 ? 0 : (row < 16384 ? 1 : 2); }

DI void fft_fwd(float2* buf, int tid) {
#pragma unroll 1
  for (int m = 8192; m >= 1; m >>= 1) {
    const float inv2m = 0.5f / (float)m;
#pragma unroll 4
    for (int i = tid; i < 8192; i += NT) {
      const int j = i & (m - 1), i0 = ((i - j) << 1) + j, i1 = i0 + m;
      const float2 a = buf[i0], b = buf[i1];
      const float f = (float)j * inv2m;
      const float wr = __builtin_amdgcn_cosf(f), wi = -__builtin_amdgcn_sinf(f);
      const float dr = a.x - b.x, di = a.y - b.y;
      buf[i0] = make_float2(a.x + b.x, a.y + b.y);
      buf[i1] = make_float2(dr * wr - di * wi, dr * wi + di * wr);
    }
    __syncthreads();
  }
}
DI void fft_inv(float2* buf, int tid) {
#pragma unroll 1
  for (int m = 1; m < 16384; m <<= 1) {
    const float inv2m = 0.5f / (float)m;
#pragma unroll 4
    for (int i = tid; i < 8192; i += NT) {
      const int j = i & (m - 1), i0 = ((i - j) << 1) + j, i1 = i0 + m;
      const float2 a = buf[i0], b0 = buf[i1];
      const float f = (float)j * inv2m;
      const float wr = __builtin_amdgcn_cosf(f), wi = __builtin_amdgcn_sinf(f);
      const float br = b0.x * wr - b0.y * wi, bi = b0.x * wi + b0.y * wr;
      buf[i0] = make_float2(a.x + br, a.y + bi);
      buf[i1] = make_float2(a.x - br, a.y - bi);
    }
    __syncthreads();
  }
}
DI int brev14(int k) { return (int)(__brev((unsigned)k) >> 18); }

DI void spec_mul(float2* buf, const float4* spec, int tid) {
#pragma unroll 2
  for (int k = tid; k <= 8192; k += NT) {
    const int nk = (16384 - k) & 16383, rk = brev14(k), rnk = brev14(nk);
    const float2 zk = buf[rk], zn = buf[rnk];
    const float ar = 0.5f * (zk.x + zn.x), ai = 0.5f * (zk.y - zn.y);
    const float tr = zk.x - zn.x, ti = zk.y + zn.y;
    const float br = 0.5f * ti, bi = -0.5f * tr;
    const float4 h = spec[k];
    const float pr = ar * h.x - ai * h.y, pi = ar * h.y + ai * h.x;
    const float qr = br * h.z - bi * h.w, qi = br * h.w + bi * h.z;
    buf[rk] = make_float2(pr - qi, pi + qr);
    if (nk != k) buf[rnk] = make_float2(pr + qi, -pi + qr);
  }
  __syncthreads();
}

DI void phase0(const Params& p, unsigned char* lds, int tid) {
  unsigned char* ws = p.ws;
  const int G = gridDim.x, bid = blockIdx.x;
  if (bid == 0 && tid < 64) ((int*)(ws + OFF_CNT))[tid] = 0;
  {
    float4* h = (float4*)(ws + OFF_HRES);
    const float4* x = (const float4*)p.x; const float4* cx = (const float4*)p.ctx;
    const int nlat = 16384 * 256, nall = TOK * 256;
    for (int i = bid * NT + tid; i < nall; i += G * NT) h[i] = i < nlat ? x[i] : cx[i - nlat];
  }
  {
    float2* rt = (float2*)(ws + OFF_ROPE);
    for (int i = bid * NT + tid; i < 8192 * 32; i += G * NT) {
      const int pos = i >> 5, f = i & 31;
      const float invf = powf(10000.f, -(float)(f & 15) / 16.f);
      const float ang = (f < 16 ? (float)(pos >> 6) : (float)(pos & 63)) * invf;
      rt[i] = make_float2(cosf(ang), sinf(ang));
    }
  }
  float* lf = (float*)lds;
  for (int it = bid; it < 4 * 96; it += G) {
    const int l = it / 96, c0 = (it % 96) * 64, kg = tid >> 6, col = tid & 63;
    const float* w = p.ada_w + (size_t)l * 1024 * 6144 + c0 + col;
    float a0 = 0.f, a1 = 0.f, a2 = 0.f;
    for (int k = kg * 128; k < kg * 128 + 128; ++k) {
      const float wv = w[(size_t)k * 6144];
      a0 += siluf(p.c[k]) * wv; a1 += siluf(p.c[1024 + k]) * wv; a2 += siluf(p.c_ctx[k]) * wv;
    }
    lf[(kg * 3 + 0) * 64 + col] = a0; lf[(kg * 3 + 1) * 64 + col] = a1; lf[(kg * 3 + 2) * 64 + col] = a2;
    __syncthreads();
    if (tid < 192) {
      const int v = tid >> 6;
      float s = p.ada_b[l * 6144 + c0 + col];
      for (int g = 0; g < 8; ++g) s += lf[(g * 3 + v) * 64 + col];
      ((float*)(ws + OFF_MOD))[(l * 3 + v) * 6144 + c0 + col] = s;
    }
    __syncthreads();
  }
  for (int it = bid; it < 4 * (1024 + 32); it += G) {
    const int l = it / 1056, r = it % 1056, isctx = r >= 1024, n = isctx ? 256 : 8192, tile = isctx ? r - 1024 : r;
    const int ps = tid >> 6, j = tid & 63, pos = tile * 8 + ps;
    float* z = lf; float* h1 = lf + 8 * 33;
    if (j < 33) {
      float val;
      if (j == 0) val = (float)pos / (float)(n - 1);
      else {
        const int kb = (j - 1) & 15;
        const float band = 1e-4f + (float)kb * ((15.f - 1e-4f) / 15.f);
        const float omega = (float)(6.283185307179586 / (double)n) * (float)pos;
        const float ph = omega * band;
        val = (j <= 16) ? cosf(ph) : -sinf(ph);
      }
      z[ps * 33 + j] = val;
    }
    __syncthreads();
    const float fr = p.filt_freq[l * 64 + j];
    float a = p.filt_b1[l * 64 + j];
    for (int e = 0; e < 33; ++e) a += z[ps * 33 + e] * p.filt_w1[(l * 33 + e) * 64 + j];
    h1[ps * 64 + j] = sinf(fr * a);
    __syncthreads();
    float a2 = p.filt_b2[l * 64 + j];
    for (int i = 0; i < 64; ++i) a2 += h1[ps * 64 + i] * p.filt_w2[(l * 64 + i) * 64 + j];
    const float h2 = sinf(fr * a2);
    if (isctx) ((float*)(ws + OFF_H2C))[((size_t)l * 256 + pos) * 64 + j] = h2;
    else ((float*)(ws + OFF_H2L))[((size_t)l * 8192 + pos) * 64 + j] = h2;
    __syncthreads();
  }
}

DI float hy_delta(int c) {
  const float mn = -3.0701134573253944f, mx = -15.350567286626972f;
  return fabsf(mn + (float)c * ((mx - mn) / 255.f));
}

DI void norm_rows(const Params& p, int layer, int which  , int tid) {
  unsigned char* ws = p.ws;
  const int lane = tid & 63, gw = blockIdx.x * 8 + (tid >> 6), nw = gridDim.x * 8;
  const float* g = (which ? p.norm2_g : p.norm1_g) + layer * 1024;
  const float* hres = (const float*)(ws + OFF_HRES);
  bf16_t* u = (bf16_t*)(ws + OFF_U);
  for (int row = gw; row < TOK; row += nw) {
    const float* mod = (const float*)(ws + OFF_MOD) + (layer * 3 + row_mod(row)) * 6144 + which * 3072;
    const f32x4* xr = (const f32x4*)(hres + (size_t)row * 1024) + lane;
    f32x4 v[4]; float s = 0.f;
#pragma unroll
    for (int j = 0; j < 4; ++j) { v[j] = xr[64 * j]; s += v[j].x * v[j].x + v[j].y * v[j].y + v[j].z * v[j].z + v[j].w * v[j].w; }
    const float rstd = rsqrtf(wave_sum(s) * (1.f / 1024.f) + EPS);
#pragma unroll
    for (int j = 0; j < 4; ++j) {
      const int col = lane * 4 + 256 * j;
      const f32x4 gg = *(const f32x4*)(g + col), sh = *(const f32x4*)(mod + col), sc = *(const f32x4*)(mod + 1024 + col);
      const f32x4 o = (v[j] * rstd * gg) * (sc + 1.f) + sh;
      u32x2 w; w.x = pk2(o.x, o.y); w.y = pk2(o.z, o.w);
      *(u32x2*)(u + (size_t)row * 1024 + col) = w;
    }
  }
}

DI void wt_item(const float* W, int K, int N, bf16_t* WT, int mode, int kt, int nt, float* tile, int tid) {
  const int k0 = kt * 64, n0 = nt * 64;
#pragma unroll
  for (int i = 0; i < 8; ++i) {
    const int k = i * 8 + (tid >> 6), n = tid & 63;
    tile[k * 65 + n] = (n0 + n < N) ? W[(size_t)(k0 + k) * N + n0 + n] : 0.f;
  }
  __syncthreads();
  {
    const int n = tid >> 3, kc = tid & 7;
    const float* s = tile + (kc * 8) * 65 + n;
    u32x4 o; o.x = pk2(s[0], s[65]); o.y = pk2(s[2 * 65], s[3 * 65]); o.z = pk2(s[4 * 65], s[5 * 65]); o.w = pk2(s[6 * 65], s[7 * 65]);
    const int nn = n0 + n; int r = nn;
    if (mode) r = (nn >> 4) * 32 + (nn & 15) + (mode == 2 ? 16 : 0);
    *(u32x4*)(WT + (size_t)r * K + k0 + kc * 8) = o;
  }
  __syncthreads();
}

DI void weight_prep(const Params& p, int layer, unsigned char* lds, int tid) {
  unsigned char* ws = p.ws; float* tile = (float*)lds;
  const int G = gridDim.x;
  const int I0 = 16 * 38, I1 = 16 * 16, I2 = 16 * 44, I3 = 16 * 44, I4 = 44 * 16;
  for (int it = blockIdx.x; it < I0 + I1 + I2 + I3 + I4; it += G) {
    int r = it;
    if (r < I0) { wt_item(p.w_in + (size_t)layer * 1024 * 2336, 1024, 2336, (bf16_t*)(ws + OFF_WIN), 0, r / 38, r % 38, tile, tid); continue; } r -= I0;
    if (r < I1) { wt_item(p.w_out + (size_t)layer * 1024 * 1024, 1024, 1024, (bf16_t*)(ws + OFF_WOUT), 0, r / 16, r % 16, tile, tid); continue; } r -= I1;
    if (r < I2) { wt_item(p.ffn_w1 + (size_t)layer * 1024 * 2816, 1024, 2816, (bf16_t*)(ws + OFF_W13), 1, r / 44, r % 44, tile, tid); continue; } r -= I2;
    if (r < I3) { wt_item(p.ffn_w3 + (size_t)layer * 1024 * 2816, 1024, 2816, (bf16_t*)(ws + OFF_W13), 2, r / 44, r % 44, tile, tid); continue; } r -= I3;
    wt_item(p.ffn_w2 + (size_t)layer * 2816 * 1024, 2816, 1024, (bf16_t*)(ws + OFF_W2), 0, r / 16, r % 16, tile, tid);
  }
}

DI void ctx_filters(const Params& p, int layer, int tid) {
  unsigned char* ws = p.ws;
  const float* h2c = (const float*)(ws + OFF_H2C) + (size_t)layer * 256 * 64;
  float* hc = (float*)(ws + OFF_HC);
  for (int t = blockIdx.x; t < 256; t += gridDim.x) {
    const float tn = (float)t / 255.f;
#pragma unroll
    for (int cc = 0; cc < 2; ++cc) {
      const int col = tid + cc * 512;
      float a = 0.f;
      for (int j = 0; j < 64; ++j) a += h2c[t * 64 + j] * p.filt_w3[((size_t)layer * 64 + j) * 1024 + col];
      hc[t * 1024 + col] = a * __expf(-tn * hy_delta(col & 255));
    }
  }
}

DI void spectra_items(const Params& p, int layer, unsigned char* lds, int tid) {
  unsigned char* ws = p.ws;
  float2* buf = (float2*)lds;
  float* w3s = (float*)(lds + 131072);
  const float* h2l = (const float*)(ws + OFF_H2L) + (size_t)layer * 8192 * 64;
  for (int it = blockIdx.x; it < 256; it += gridDim.x) {
    const int o = it >> 7, pr = it & 127, ca = 2 * pr;
    if (tid < 256) {
      const int j = tid >> 2, q = tid & 3, sign = q >> 1, ch = ca + (q & 1);
      w3s[tid] = p.filt_w3[((size_t)layer * 64 + j) * 1024 + o * 512 + sign * 256 + ch];
    }
    __syncthreads();
    const float da = hy_delta(ca), db = hy_delta(ca + 1);
#pragma unroll 1
    for (int t = tid; t < 8192; t += NT) {
      const f32x4* hr = (const f32x4*)(h2l + (size_t)t * 64);
      float a0 = 0.f, a1 = 0.f, a2 = 0.f, a3 = 0.f;
#pragma unroll 1
      for (int jj = 0; jj < 16; ++jj) {
        const f32x4 hv = hr[jj];
#pragma unroll
        for (int e = 0; e < 4; ++e) {
          const float hvv = hv[e]; const f32x4 w = *(const f32x4*)(w3s + (jj * 4 + e) * 4);
          a0 += hvv * w.x; a1 += hvv * w.y; a2 += hvv * w.z; a3 += hvv * w.w;
        }
      }
      const float tn = (float)t / 8191.f, wa = __expf(-tn * da), wb = __expf(-tn * db);
      buf[t] = make_float2(a0 * wa, a1 * wb);
      if (t == 0) buf[8192] = make_float2(0.f, 0.f);
      else buf[16384 - t] = make_float2(a2 * wa, a3 * wb);
    }
    __syncthreads();
    fft_fwd(buf, tid);
    float4* spec = (float4*)(ws + OFF_SPEC) + (size_t)it * 8193;
#pragma unroll 2
    for (int k = tid; k <= 8192; k += NT) {
      const int nk = (16384 - k) & 16383;
      const float2 zk = buf[brev14(k)], zn = buf[brev14(nk)];
      const float tr = zk.x - zn.x, ti = zk.y + zn.y;
      spec[k] = make_float4(0.5f * (zk.x + zn.x), 0.5f * (zk.y - zn.y), 0.5f * ti, -0.5f * tr);
    }
    __syncthreads();
  }
}

#define MFMA16(a, b, c) __builtin_amdgcn_mfma_f32_16x16x32_bf16((a), (b), (c), 0, 0, 0)
#define MFMA32(a, b, c) __builtin_amdgcn_mfma_f32_32x32x16_bf16((a), (b), (c), 0, 0, 0)
#define LSA 72

DI float log_sigmoid(float z) { return fminf(z, 0.f) - log1pf(__expf(-fabsf(z))); }

DI void inproj_epi(const Params& p, int layer, const float* st, int row, int cb, int lane) {
  unsigned char* ws = p.ws;
  const bool isctx = row >= 16384;
  int b, pos, tok;
  if (!isctx) { b = row >> 13; pos = row & 8191; tok = pos; } else { const int r2 = row - 16384; b = r2 >> 8; pos = r2 & 255; tok = 8192 + pos; }
  if (cb >= 2368) return;
  float v[64];
#pragma unroll
  for (int c = 0; c < 64; ++c) v[c] = st[lane * 65 + c];
  if (cb < 640) {
    const bool isq = cb < 512;
    const float* g = (isq ? p.q_norm_g : p.k_norm_g) + layer * 64;
    float ss = 0.f;
#pragma unroll
    for (int c = 0; c < 64; ++c) ss += v[c] * v[c];
    const float rstd = rsqrtf(ss * (1.f / 64.f) + EPS);
#pragma unroll
    for (int c = 0; c < 64; ++c) v[c] = v[c] * rstd * g[c];
    if (!isctx) {
      const float2* rt = (const float2*)(ws + OFF_ROPE) + (size_t)pos * 32;
#pragma unroll
      for (int c = 0; c < 32; ++c) { const float2 cs = rt[c]; const float x1 = v[c], x2 = v[c + 32]; v[c] = x1 * cs.x - x2 * cs.y; v[c + 32] = x1 * cs.y + x2 * cs.x; }
    }
    bf16_t* dst; float sc = 1.f;
    if (isq) { dst = (bf16_t*)(ws + OFF_Q) + (size_t)row * 512 + cb; sc = 0.125f * 1.4426950408889634f; }
    else dst = (bf16_t*)(ws + OFF_K) + ((size_t)(b * 2 + ((cb - 512) >> 6)) * NKEY + tok) * 64;
#pragma unroll
    for (int c8 = 0; c8 < 8; ++c8) {
      u32x4 w; w.x = pk2(v[c8 * 8] * sc, v[c8 * 8 + 1] * sc); w.y = pk2(v[c8 * 8 + 2] * sc, v[c8 * 8 + 3] * sc);
      w.z = pk2(v[c8 * 8 + 4] * sc, v[c8 * 8 + 5] * sc); w.w = pk2(v[c8 * 8 + 6] * sc, v[c8 * 8 + 7] * sc);
      *(u32x4*)(dst + c8 * 8) = w;
    }
  } else if (cb < 768) {
    bf16_t* dst = (bf16_t*)(ws + OFF_VT) + ((size_t)(b * 2 + ((cb - 640) >> 6)) * 64) * NKEY + tok;
#pragma unroll
    for (int c = 0; c < 64; ++c) dst[(size_t)c * NKEY] = f2bf(v[c]);
  } else if (cb < 1536) {
    bf16_t* dst = (bf16_t*)(ws + OFF_HYP) + ((size_t)b * 768 + (cb - 768)) * NKEY + tok;
#pragma unroll
    for (int c = 0; c < 64; ++c) dst[(size_t)c * NKEY] = f2bf(v[c]);
  } else if (cb < 2304) {
    float* dst; float sc = 1.f;
    if (cb < 1664) { dst = (float*)(ws + OFF_GQ) + (size_t)row * 128 + (cb - 1536); sc = 0.17677669529663687f; }
    else if (cb < 1792) dst = (float*)(ws + OFF_GK) + (size_t)row * 128 + (cb - 1664);
    else if (cb < 2048) dst = (float*)(ws + OFF_GV) + (size_t)row * 256 + (cb - 1792);
    else dst = (float*)(ws + OFF_GR) + (size_t)row * 256 + (cb - 2048);
#pragma unroll
    for (int c4 = 0; c4 < 16; ++c4) *(f32x4*)(dst + c4 * 4) = (f32x4){v[c4 * 4] * sc, v[c4 * 4 + 1] * sc, v[c4 * 4 + 2] * sc, v[c4 * 4 + 3] * sc};
  } else {
#pragma unroll
    for (int d = 0; d < 2; ++d) {
      const float* gw = p.gla_gate_w + ((size_t)(layer * 2 + d) * 16) * 128;
      const float* gb = p.gla_gate_b + (size_t)(layer * 2 + d) * 128;
      float* dst = (float*)(ws + (d ? OFF_LGB : OFF_LGF)) + (size_t)row * 128;
      for (int c4 = 0; c4 < 32; ++c4) {
        f32x4 z = *(const f32x4*)(gb + c4 * 4);
#pragma unroll
        for (int r = 0; r < 16; ++r) { const f32x4 w = *(const f32x4*)(gw + r * 128 + c4 * 4); z += w * v[d * 16 + r]; }
        *(f32x4*)(dst + c4 * 4) = (f32x4){log_sigmoid(z.x) * 0.0625f, log_sigmoid(z.y) * 0.0625f, log_sigmoid(z.z) * 0.0625f, log_sigmoid(z.w) * 0.0625f};
      }
    }
  }
}

template <int EPI>
DI void gemm_phase(const Params& p, unsigned char* lds, const bf16_t* A, const bf16_t* Bt, int N, int K, int layer, int goff, int tid) {
  unsigned char* ws = p.ws;
  const int lane = tid & 63, wave = tid >> 6, wm = wave >> 1, wn = wave & 1, fr = lane & 15, fq = lane >> 4;
  const int tilesN = N / 128, ntiles = (TOK / 256) * tilesN, nk = K / 64;
  bf16_t* As = (bf16_t*)lds;
  bf16_t* Bs = (bf16_t*)(lds + 73728);
  for (int tile = blockIdx.x; tile < ntiles; tile += gridDim.x) {
    const int tm = tile / tilesN, tn = tile % tilesN;
    const bf16_t* Ag = A + (size_t)(tm * 256) * K;
    const bf16_t* Bg = Bt + (size_t)(tn * 128) * K;
    f32x4 acc[4][4];
#pragma unroll
    for (int m = 0; m < 4; ++m)
#pragma unroll
      for (int n = 0; n < 4; ++n) acc[m][n] = (f32x4){0.f, 0.f, 0.f, 0.f};
    u32x4 ra[4], rb[2];
#pragma unroll
    for (int i = 0; i < 4; ++i) { const int c = tid + NT * i; ra[i] = *(const u32x4*)(Ag + (size_t)(c >> 3) * K + (c & 7) * 8); }
#pragma unroll
    for (int i = 0; i < 2; ++i) { const int c = tid + NT * i; rb[i] = *(const u32x4*)(Bg + (size_t)(c >> 3) * K + (c & 7) * 8); }
#pragma unroll
    for (int i = 0; i < 4; ++i) { const int c = tid + NT * i; *(u32x4*)(As + (c >> 3) * LSA + (c & 7) * 8) = ra[i]; }
#pragma unroll
    for (int i = 0; i < 2; ++i) { const int c = tid + NT * i; *(u32x4*)(Bs + (c >> 3) * LSA + (c & 7) * 8) = rb[i]; }
    __syncthreads();
    for (int kt = 0; kt < nk; ++kt) {
      const int cur = kt & 1;
      if (kt + 1 < nk) {
        const int k0 = (kt + 1) * 64;
#pragma unroll
        for (int i = 0; i < 4; ++i) { const int c = tid + NT * i; ra[i] = *(const u32x4*)(Ag + (size_t)(c >> 3) * K + k0 + (c & 7) * 8); }
#pragma unroll
        for (int i = 0; i < 2; ++i) { const int c = tid + NT * i; rb[i] = *(const u32x4*)(Bg + (size_t)(c >> 3) * K + k0 + (c & 7) * 8); }
      }
      const bf16_t* as = As + cur * (256 * LSA) + (wm * 64 + fr) * LSA + fq * 8;
      const bf16_t* bs = Bs + cur * (128 * LSA) + (wn * 64 + fr) * LSA + fq * 8;
#pragma unroll
      for (int ks = 0; ks < 2; ++ks) {
        bf16x8 af[4], bfr[4];
#pragma unroll
        for (int m = 0; m < 4; ++m) af[m] = *(const bf16x8*)(as + m * 16 * LSA + ks * 32);
#pragma unroll
        for (int n = 0; n < 4; ++n) bfr[n] = *(const bf16x8*)(bs + n * 16 * LSA + ks * 32);
#pragma unroll
        for (int m = 0; m < 4; ++m)
#pragma unroll
          for (int n = 0; n < 4; ++n) acc[m][n] = MFMA16(bfr[n], af[m], acc[m][n]);
      }
      if (kt + 1 < nk) {
        const int nb = cur ^ 1;
#pragma unroll
        for (int i = 0; i < 4; ++i) { const int c = tid + NT * i; *(u32x4*)(As + nb * (256 * LSA) + (c >> 3) * LSA + (c & 7) * 8) = ra[i]; }
#pragma unroll
        for (int i = 0; i < 2; ++i) { const int c = tid + NT * i; *(u32x4*)(Bs + nb * (128 * LSA) + (c >> 3) * LSA + (c & 7) * 8) = rb[i]; }
      }
      __syncthreads();
    }
    const int row0 = tm * 256 + wm * 64, col0 = tn * 128 + wn * 64;
    if (EPI == 0) {
      float* st = (float*)lds + wave * (64 * 65);
#pragma unroll
      for (int m = 0; m < 4; ++m)
#pragma unroll
        for (int n = 0; n < 4; ++n)
#pragma unroll
          for (int j = 0; j < 4; ++j) st[(m * 16 + fr) * 65 + n * 16 + fq * 4 + j] = acc[m][n][j];
      __syncthreads();
      inproj_epi(p, layer, st, row0 + lane, col0, lane);
      __syncthreads();
    } else if (EPI == 1) {
      float* hres = (float*)(ws + OFF_HRES);
      const float* gm = (const float*)(ws + OFF_MOD) + (layer * 3 + row_mod(row0)) * 6144 + goff;
#pragma unroll
      for (int m = 0; m < 4; ++m)
#pragma unroll
        for (int n = 0; n < 4; ++n) {
          const int row = row0 + m * 16 + fr, col = col0 + n * 16 + fq * 4;
          f32x4* hp = (f32x4*)(hres + (size_t)row * 1024 + col);
          const f32x4 g = *(const f32x4*)(gm + col);
          *hp = *hp + g * acc[m][n];
        }
    } else {
      bf16_t* hm = (bf16_t*)(ws + OFF_HMID);
#pragma unroll
      for (int m = 0; m < 4; ++m)
#pragma unroll
        for (int n = 0; n < 4; n += 2) {
          const int row = row0 + m * 16 + fr, hid = ((tn * 8 + wn * 4 + n) >> 1) * 16 + fq * 4;
          const f32x4 a = acc[m][n], g = acc[m][n + 1];
          u32x2 w; w.x = pk2(siluf(a.x) * g.x, siluf(a.y) * g.y); w.y = pk2(siluf(a.z) * g.z, siluf(a.w) * g.w);
          *(u32x2*)(hm + (size_t)row * FFH + hid) = w;
        }
    }
  }
}

DI void attn_unit(const Params& p, unsigned char* lds, int layer, int b, int head, int qrow0, int key0, int nkeys, int tid) {
  unsigned char* ws = p.ws;
  const int lane = tid & 63, wave = tid >> 6, l31 = lane & 31, h = lane >> 5, kvh = head >> 2;
  const bf16_t* Kg = (const bf16_t*)(ws + OFF_K) + ((size_t)(b * 2 + kvh) * NKEY + key0) * 64;
  const bf16_t* Vg = (const bf16_t*)(ws + OFF_VT) + ((size_t)(b * 2 + kvh) * 64) * NKEY + key0;
  bf16_t* Ks = (bf16_t*)lds;
  bf16_t* Vs = (bf16_t*)(lds + 18432);
  const int qrow = qrow0 + wave * 32 + l31;
  bf16x8 qf[4];
#pragma unroll
  for (int s = 0; s < 4; ++s) qf[s] = *(const bf16x8*)((const bf16_t*)(ws + OFF_Q) + (size_t)qrow * 512 + head * 64 + 16 * s + 8 * h);
  f32x16 o0, o1;
#pragma unroll
  for (int i = 0; i < 16; ++i) { o0[i] = 0.f; o1[i] = 0.f; }
  float mrun = -1e30f, lsum = 0.f;
  const int ntile = nkeys >> 6, lr = tid >> 3, lc = tid & 7;
  u32x4 rk = *(const u32x4*)(Kg + (size_t)lr * 64 + lc * 8);
  u32x4 rv = *(const u32x4*)(Vg + (size_t)lr * NKEY + lc * 8);
  __syncthreads();
  *(u32x4*)(Ks + lr * 72 + lc * 8) = rk;
  *(u32x2*)(Vs + lr * 68 + lc * 8) = (u32x2){rv.x, rv.y};
  *(u32x2*)(Vs + lr * 68 + lc * 8 + 4) = (u32x2){rv.z, rv.w};
  __syncthreads();
  for (int t = 0; t < ntile; ++t) {
    const int cur = t & 1;
    if (t + 1 < ntile) {
      rk = *(const u32x4*)(Kg + (size_t)((t + 1) * 64 + lr) * 64 + lc * 8);
      rv = *(const u32x4*)(Vg + (size_t)lr * NKEY + (t + 1) * 64 + lc * 8);
    }
    const bf16_t* ks = Ks + cur * (64 * 72);
    const bf16_t* vs = Vs + cur * (64 * 68);
    f32x16 s0, s1;
#pragma unroll
    for (int i = 0; i < 16; ++i) { s0[i] = 0.f; s1[i] = 0.f; }
#pragma unroll
    for (int s = 0; s < 4; ++s) {
      const bf16x8 a0 = *(const bf16x8*)(ks + l31 * 72 + 16 * s + 8 * h);
      const bf16x8 a1 = *(const bf16x8*)(ks + (32 + l31) * 72 + 16 * s + 8 * h);
      s0 = MFMA32(a0, qf[s], s0); s1 = MFMA32(a1, qf[s], s1);
    }
    float mx = s0[0];
#pragma unroll
    for (int i = 1; i < 16; ++i) mx = fmaxf(mx, s0[i]);
#pragma unroll
    for (int i = 0; i < 16; ++i) mx = fmaxf(mx, s1[i]);
    mx = fmaxf(mx, __shfl_xor(mx, 32));
    const float mnew = fmaxf(mrun, mx), alpha = __builtin_amdgcn_exp2f(mrun - mnew);
    mrun = mnew;
    float ps = 0.f;
#pragma unroll
    for (int i = 0; i < 16; ++i) { s0[i] = __builtin_amdgcn_exp2f(s0[i] - mnew); s1[i] = __builtin_amdgcn_exp2f(s1[i] - mnew); ps += s0[i] + s1[i]; }
    lsum = lsum * alpha + ps;
#pragma unroll
    for (int i = 0; i < 16; ++i) { o0[i] *= alpha; o1[i] *= alpha; }
#pragma unroll
    for (int kk = 0; kk < 4; ++kk) {
      u32x4 pw;
      if (kk == 0) { pw.x = pk2(s0[0], s0[1]); pw.y = pk2(s0[2], s0[3]); pw.z = pk2(s0[4], s0[5]); pw.w = pk2(s0[6], s0[7]); }
      else if (kk == 1) { pw.x = pk2(s0[8], s0[9]); pw.y = pk2(s0[10], s0[11]); pw.z = pk2(s0[12], s0[13]); pw.w = pk2(s0[14], s0[15]); }
      else if (kk == 2) { pw.x = pk2(s1[0], s1[1]); pw.y = pk2(s1[2], s1[3]); pw.z = pk2(s1[4], s1[5]); pw.w = pk2(s1[6], s1[7]); }
      else { pw.x = pk2(s1[8], s1[9]); pw.y = pk2(s1[10], s1[11]); pw.z = pk2(s1[12], s1[13]); pw.w = pk2(s1[14], s1[15]); }
      const bf16x8 pf = __builtin_bit_cast(bf16x8, pw);
      const int kb = 16 * kk + 4 * h;
      {
        const s16x4 lo = *(const s16x4*)(vs + l31 * 68 + kb), hi = *(const s16x4*)(vs + l31 * 68 + kb + 8);
        o0 = MFMA32(__builtin_shufflevector(lo, hi, 0, 1, 2, 3, 4, 5, 6, 7), pf, o0);
      }
      {
        const s16x4 lo = *(const s16x4*)(vs + (32 + l31) * 68 + kb), hi = *(const s16x4*)(vs + (32 + l31) * 68 + kb + 8);
        o1 = MFMA32(__builtin_shufflevector(lo, hi, 0, 1, 2, 3, 4, 5, 6, 7), pf, o1);
      }
    }
    if (t + 1 < ntile) {
      const int nb = cur ^ 1;
      *(u32x4*)(Ks + nb * (64 * 72) + lr * 72 + lc * 8) = rk;
      *(u32x2*)(Vs + nb * (64 * 68) + lr * 68 + lc * 8) = (u32x2){rv.x, rv.y};
      *(u32x2*)(Vs + nb * (64 * 68) + lr * 68 + lc * 8 + 4) = (u32x2){rv.z, rv.w};
    }
    __syncthreads();
  }
  const float ltot = lsum + __shfl_xor(lsum, 32), inv = 1.f / ltot;
  float ss = 0.f;
#pragma unroll
  for (int i = 0; i < 16; ++i) { o0[i] *= inv; o1[i] *= inv; ss += o0[i] * o0[i] + o1[i] * o1[i]; }
  ss += __shfl_xor(ss, 32);
  const float rstd = rsqrtf(ss * (1.f / 64.f) + EPS);
  const float* g = p.out_norm_g + layer * 1024 + head * 64;
  bf16_t* dst = (bf16_t*)(ws + OFF_U) + (size_t)qrow * 1024 + head * 64;
#pragma unroll
  for (int i4 = 0; i4 < 4; ++i4) {
    const int d = 8 * i4 + 4 * h;
    const f32x4 g0 = *(const f32x4*)(g + d), g1 = *(const f32x4*)(g + 32 + d);
    u32x2 w0, w1;
    w0.x = pk2(o0[4 * i4] * rstd * g0.x, o0[4 * i4 + 1] * rstd * g0.y); w0.y = pk2(o0[4 * i4 + 2] * rstd * g0.z, o0[4 * i4 + 3] * rstd * g0.w);
    w1.x = pk2(o1[4 * i4] * rstd * g1.x, o1[4 * i4 + 1] * rstd * g1.y); w1.y = pk2(o1[4 * i4 + 2] * rstd * g1.z, o1[4 * i4 + 3] * rstd * g1.w);
    *(u32x2*)(dst + d) = w0; *(u32x2*)(dst + 32 + d) = w1;
  }
}

DI float hy_sc(const bf16_t* prow, int t, int n, float w0, float w1, float w2, float bias) {
  const float xm = t > 0 ? bf2f(prow[t - 1]) : 0.f, x0 = bf2f(prow[t]), xp = t + 1 < n ? bf2f(prow[t + 1]) : 0.f;
  return w0 * xm + w1 * x0 + w2 * xp + bias;
}

DI void hyena_lat_item(const Params& p, unsigned char* lds, int layer, int b, int pr, int tid) {
  unsigned char* ws = p.ws;
  float2* buf = (float2*)lds;
  const int ca = 2 * pr;
  const bf16_t* hyp = (const bf16_t*)(ws + OFF_HYP) + (size_t)b * 768 * NKEY;
  const float* cw = p.hy_conv_w + (size_t)layer * 3 * 768; const float* cbias = p.hy_conv_b + (size_t)layer * 768;
  const float* hb = p.hy_bias + (size_t)layer * 512;
  float w[3][2][4];
#pragma unroll
  for (int s = 0; s < 3; ++s)
#pragma unroll
    for (int e = 0; e < 2; ++e) { const int c = s * 256 + ca + e; w[s][e][0] = cw[c]; w[s][e][1] = cw[768 + c]; w[s][e][2] = cw[1536 + c]; w[s][e][3] = cbias[c]; }
  const bf16_t* pv0 = hyp + (size_t)(ca) * NKEY; const bf16_t* pv1 = hyp + (size_t)(ca + 1) * NKEY;
  const bf16_t* p10 = hyp + (size_t)(256 + ca) * NKEY; const bf16_t* p11 = hyp + (size_t)(256 + ca + 1) * NKEY;
  const bf16_t* p20 = hyp + (size_t)(512 + ca) * NKEY; const bf16_t* p21 = hyp + (size_t)(512 + ca + 1) * NKEY;
  float* outa = (float*)(ws + OFF_HYRAW) + ((size_t)b * 256 + ca) * NKEY; float* outb = outa + NKEY;
  const float b0a = hb[ca], b0b = hb[ca + 1], b1a = hb[256 + ca], b1b = hb[256 + ca + 1];
  __syncthreads();
#pragma unroll 2
  for (int t = tid; t < 8192; t += NT) {
    buf[t] = make_float2(hy_sc(pv0, t, 8192, w[0][0][0], w[0][0][1], w[0][0][2], w[0][0][3]), hy_sc(pv1, t, 8192, w[0][1][0], w[0][1][1], w[0][1][2], w[0][1][3]));
    buf[8192 + t] = make_float2(0.f, 0.f);
  }
  __syncthreads();
  fft_fwd(buf, tid);
  spec_mul(buf, (const float4*)(ws + OFF_SPEC) + (size_t)(0 * 128 + pr) * 8193, tid);
  fft_inv(buf, tid);
#pragma unroll 2
  for (int t = tid; t < 8192; t += NT) {
    const float2 y = buf[t];
    const float va = hy_sc(pv0, t, 8192, w[0][0][0], w[0][0][1], w[0][0][2], w[0][0][3]), vb = hy_sc(pv1, t, 8192, w[0][1][0], w[0][1][1], w[0][1][2], w[0][1][3]);
    const float xa = hy_sc(p10, t, 8192, w[1][0][0], w[1][0][1], w[1][0][2], w[1][0][3]), xb = hy_sc(p11, t, 8192, w[1][1][0], w[1][1][1], w[1][1][2], w[1][1][3]);
    const float za = xa * (y.x * (1.f / 16384.f) + va * b0a), zb = xb * (y.y * (1.f / 16384.f) + vb * b0b);
    outa[t] = za; outb[t] = zb;
    buf[t] = make_float2(za, zb);
  }
#pragma unroll 2
  for (int t = tid; t < 8192; t += NT) buf[8192 + t] = make_float2(0.f, 0.f);
  __syncthreads();
  fft_fwd(buf, tid);
  spec_mul(buf, (const float4*)(ws + OFF_SPEC) + (size_t)(1 * 128 + pr) * 8193, tid);
  fft_inv(buf, tid);
#pragma unroll 2
  for (int t = tid; t < 8192; t += NT) {
    const float2 y = buf[t];
    const float xa = hy_sc(p20, t, 8192, w[2][0][0], w[2][0][1], w[2][0][2], w[2][0][3]), xb = hy_sc(p21, t, 8192, w[2][1][0], w[2][1][1], w[2][1][2], w[2][1][3]);
    const float za = outa[t], zb = outb[t];
    outa[t] = xa * (y.x * (1.f / 16384.f) + za * b1a);
    outb[t] = xb * (y.y * (1.f / 16384.f) + zb * b1b);
  }
  __syncthreads();
}

DI void hyena_ctx_item(const Params& p, unsigned char* lds, int layer, int b, int pr, int tid) {
  unsigned char* ws = p.ws;
  float* lf = (float*)lds;
  const int cs = tid >> 8, t = tid & 255, c = 2 * pr + cs;
  float* vv = lf + cs * 256; float* zz = lf + 512 + cs * 256;
  float* hp0 = lf + 1024 + cs * 256; float* hn0 = lf + 1536 + cs * 256; float* hp1 = lf + 2048 + cs * 256; float* hn1 = lf + 2560 + cs * 256;
  const bf16_t* hyp = (const bf16_t*)(ws + OFF_HYP) + (size_t)b * 768 * NKEY + 8192;
  const float* cw = p.hy_conv_w + (size_t)layer * 3 * 768; const float* cbias = p.hy_conv_b + (size_t)layer * 768;
  const float* hb = p.hy_bias + (size_t)layer * 512;
  const float* hc = (const float*)(ws + OFF_HC) + (size_t)t * 1024;
  const float uv = hy_sc(hyp + (size_t)c * NKEY, t, 256, cw[c], cw[768 + c], cw[1536 + c], cbias[c]);
  const float x1 = hy_sc(hyp + (size_t)(256 + c) * NKEY, t, 256, cw[256 + c], cw[768 + 256 + c], cw[1536 + 256 + c], cbias[256 + c]);
  const float x2 = hy_sc(hyp + (size_t)(512 + c) * NKEY, t, 256, cw[512 + c], cw[768 + 512 + c], cw[1536 + 512 + c], cbias[512 + c]);
  __syncthreads();
  vv[t] = uv; hp0[t] = hc[c]; hn0[t] = hc[256 + c]; hp1[t] = hc[512 + c]; hn1[t] = hc[768 + c];
  __syncthreads();
  float y = 0.f;
  for (int s = 0; s < 256; ++s) y += (s <= t ? hp0[t - s] : hn0[s - t]) * vv[s];
  const float z = x1 * (y + hb[c] * uv);
  zz[t] = z;
  __syncthreads();
  float y2 = 0.f;
  for (int s = 0; s < 256; ++s) y2 += (s <= t ? hp1[t - s] : hn1[s - t]) * zz[s];
  ((float*)(ws + OFF_HYRAW))[((size_t)b * 256 + c) * NKEY + 8192 + t] = x2 * (y2 + hb[256 + c] * z);
  __syncthreads();
}

DI void hyena_norm_item(const Params& p, unsigned char* lds, int layer, int b, int tt, int tid) {
  unsigned char* ws = p.ws;
  float* tile = (float*)lds;
  float* ssb = tile + 256 * 65;
  const int lane = tid & 63, wave = tid >> 6;
  const float* src = (const float*)(ws + OFF_HYRAW) + (size_t)b * 256 * NKEY + tt * 64;
  __syncthreads();
#pragma unroll 4
  for (int i = 0; i < 32; ++i) { const int ch = i * 8 + wave; tile[ch * 65 + lane] = src[(size_t)ch * NKEY + lane]; }
  __syncthreads();
  float v[32]; float ss = 0.f;
#pragma unroll
  for (int j = 0; j < 32; ++j) { v[j] = tile[(wave * 32 + j) * 65 + lane]; ss += v[j] * v[j]; }
  ssb[wave * 64 + lane] = ss;
  __syncthreads();
  const float rstd = rsqrtf((ssb[(wave & ~1) * 64 + lane] + ssb[(wave | 1) * 64 + lane]) * (1.f / 64.f) + EPS);
  const int tok = tt * 64 + lane;
  const int row = tok < 8192 ? b * 8192 + tok : 16384 + b * 256 + (tok - 8192);
  const float* g = p.out_norm_g + layer * 1024 + 512 + wave * 32;
  bf16_t* dst = (bf16_t*)(ws + OFF_U) + (size_t)row * 1024 + 512 + wave * 32;
#pragma unroll
  for (int c8 = 0; c8 < 4; ++c8) {
    u32x4 w;
    w.x = pk2(v[c8 * 8] * rstd * g[c8 * 8], v[c8 * 8 + 1] * rstd * g[c8 * 8 + 1]); w.y = pk2(v[c8 * 8 + 2] * rstd * g[c8 * 8 + 2], v[c8 * 8 + 3] * rstd * g[c8 * 8 + 3]);
    w.z = pk2(v[c8 * 8 + 4] * rstd * g[c8 * 8 + 4], v[c8 * 8 + 5] * rstd * g[c8 * 8 + 5]); w.w = pk2(v[c8 * 8 + 6] * rstd * g[c8 * 8 + 6], v[c8 * 8 + 7] * rstd * g[c8 * 8 + 7]);
    *(u32x4*)(dst + c8 * 8) = w;
  }
}

DI int gla_row(int b, int sc, int i) { return sc < 128 ? b * 8192 + sc * 64 + i : 16384 + b * 256 + (sc - 128) * 64 + i; }

DI void gla_local_item(const Params& p, unsigned char* lds, int b, int sc, int h, int tid) {
  unsigned char* ws = p.ws;
  float* lf = (float*)lds;
  float* kt = lf;
  float* vs = lf + 2 * 64 * 33;
  float* lg = vs + 64 * 64;
  const int row0 = gla_row(b, sc, 0);
  const float* gk = (const float*)(ws + OFF_GK) + (size_t)row0 * 128 + h * 32;
  const float* gv = (const float*)(ws + OFF_GV) + (size_t)row0 * 256 + h * 64;
  const float* lgf = (const float*)(ws + OFF_LGF) + (size_t)row0 * 128 + h * 32;
  const float* lgb = (const float*)(ws + OFF_LGB) + (size_t)row0 * 128 + h * 32;
  __syncthreads();
  for (int e = tid; e < 2048; e += NT) { const int i = e >> 5, d = e & 31; const float kk = gk[i * 128 + d]; kt[i * 33 + d] = kk; kt[64 * 33 + i * 33 + d] = kk; lg[i * 33 + d] = lgf[i * 128 + d]; lg[64 * 33 + i * 33 + d] = lgb[i * 128 + d]; }
  for (int e = tid; e < 4096; e += NT) { const int i = e >> 6, d = e & 63; vs[e] = gv[i * 256 + d]; }
  __syncthreads();
  if (tid < 64) {
    const int dir = tid >> 5, d = tid & 31;
    float* l = lg + dir * 64 * 33; float* k = kt + dir * 64 * 33;
    float tot = 0.f;
    for (int i = 0; i < 64; ++i) tot += l[i * 33 + d];
    float cum = 0.f;
    if (dir == 0) { for (int i = 0; i < 64; ++i) { cum += l[i * 33 + d]; k[i * 33 + d] *= __expf(tot - cum); } }
    else { for (int i = 63; i >= 0; --i) { cum += l[i * 33 + d]; k[i * 33 + d] *= __expf(tot - cum); } }
    ((float*)(ws + OFF_DEC))[(((size_t)(dir * 2 + b) * 4 + h) * 132 + sc) * 32 + d] = __expf(tot);
  }
  __syncthreads();
  {
    const int dir = tid >> 8, dk = (tid >> 3) & 31, dv0 = (tid & 7) * 8;
    const float* k = kt + dir * 64 * 33 + dk;
    float acc[8];
#pragma unroll
    for (int e = 0; e < 8; ++e) acc[e] = 0.f;
    for (int j = 0; j < 64; ++j) {
      const float kk = k[j * 33];
      const f32x4 v0 = *(const f32x4*)(vs + j * 64 + dv0), v1 = *(const f32x4*)(vs + j * 64 + dv0 + 4);
      acc[0] += kk * v0.x; acc[1] += kk * v0.y; acc[2] += kk * v0.z; acc[3] += kk * v0.w;
      acc[4] += kk * v1.x; acc[5] += kk * v1.y; acc[6] += kk * v1.z; acc[7] += kk * v1.w;
    }
    float* dst = (float*)(ws + OFF_KV) + ((((size_t)(dir * 2 + b) * 4 + h) * 132 + sc) * 32 + dk) * 64 + dv0;
    *(f32x4*)dst = (f32x4){acc[0], acc[1], acc[2], acc[3]}; *(f32x4*)(dst + 4) = (f32x4){acc[4], acc[5], acc[6], acc[7]};
  }
}

DI void gla_scan(const Params& p, int tid) {
  unsigned char* ws = p.ws;
  for (int blk = blockIdx.x; blk < 64; blk += gridDim.x) {
    const int chain = blk >> 2, e = (blk & 3) * 512 + tid, dk = e >> 6, dir = chain >> 3;
    float* kv = (float*)(ws + OFF_KV) + (size_t)chain * 132 * 2048 + e;
    const float* dec = (const float*)(ws + OFF_DEC) + (size_t)chain * 132 * 32 + dk;
    float state = 0.f;
    for (int s0 = 0; s0 < 132; s0 += 4) {
      float kvv[4], dd[4]; int scs[4];
#pragma unroll
      for (int q = 0; q < 4; ++q) {
        const int s = s0 + q;
        const int sc = dir == 0 ? (s < 4 ? 128 + s : s - 4) : 131 - s;
        scs[q] = sc; kvv[q] = kv[(size_t)sc * 2048]; dd[q] = dec[sc * 32];
      }
#pragma unroll
      for (int q = 0; q < 4; ++q) { kv[(size_t)scs[q] * 2048] = state; state = dd[q] * state + kvv[q]; }
    }
  }
}

DI void gla_out_item(const Params& p, unsigned char* lds, int layer, int b, int sc, int h, int tid) {
  unsigned char* ws = p.ws;
  float* lf = (float*)lds;
  float* qf = lf;
  float* qb = qf + 64 * 33;
  float* kf = qb + 64 * 33;
  float* kb = kf + 64 * 33;
  float* gf = kb + 64 * 33;
  float* gb = gf + 64 * 33;
  float* vs = gb + 64 * 33;
  float* S = vs + 4096;
  float* spf = S + 64 * 65;
  float* spb = spf + 2048;
  const int row0 = gla_row(b, sc, 0);
  const float* gq = (const float*)(ws + OFF_GQ) + (size_t)row0 * 128 + h * 32;
  const float* gk = (const float*)(ws + OFF_GK) + (size_t)row0 * 128 + h * 32;
  const float* gv = (const float*)(ws + OFF_GV) + (size_t)row0 * 256 + h * 64;
  const float* lgf = (const float*)(ws + OFF_LGF) + (size_t)row0 * 128 + h * 32;
  const float* lgb = (const float*)(ws + OFF_LGB) + (size_t)row0 * 128 + h * 32;
  const float* pf = (const float*)(ws + OFF_KV) + (((size_t)(0 * 2 + b) * 4 + h) * 132 + sc) * 2048;
  const float* pb = (const float*)(ws + OFF_KV) + (((size_t)(1 * 2 + b) * 4 + h) * 132 + sc) * 2048;
  __syncthreads();
  for (int e = tid; e < 2048; e += NT) {
    const int i = e >> 5, d = e & 31; const float q = gq[i * 128 + d], k = gk[i * 128 + d];
    qf[i * 33 + d] = q; qb[i * 33 + d] = q; kf[i * 33 + d] = k; kb[i * 33 + d] = k; gf[i * 33 + d] = lgf[i * 128 + d]; gb[i * 33 + d] = lgb[i * 128 + d];
    spf[e] = pf[e]; spb[e] = pb[e];
  }
  for (int e = tid; e < 4096; e += NT) { const int i = e >> 6, d = e & 63; vs[e] = gv[i * 256 + d]; }
  __syncthreads();
  if (tid < 64) {
    const int dir = tid >> 5, d = tid & 31;
    float cum = 0.f;
    if (dir == 0) { for (int i = 0; i < 64; ++i) { cum += gf[i * 33 + d]; qf[i * 33 + d] *= __expf(cum); kf[i * 33 + d] *= __expf(-cum); } }
    else { for (int i = 63; i >= 0; --i) { cum += gb[i * 33 + d]; qb[i * 33 + d] *= __expf(cum); kb[i * 33 + d] *= __expf(-cum); } }
  }
  __syncthreads();
  {
    const int i = tid >> 3;
#pragma unroll
    for (int jj = 0; jj < 8; ++jj) {
      const int j = (tid & 7) + 8 * jj;
      float s = 0.f;
      if (j <= i) { for (int d = 0; d < 32; ++d) s += qf[i * 33 + d] * kf[j * 33 + d]; }
      if (j >= i) { for (int d = 0; d < 32; ++d) s += qb[i * 33 + d] * kb[j * 33 + d]; }
      S[i * 65 + j] = s;
    }
  }
  __syncthreads();
  {
    const int i = tid >> 3, dv0 = (tid & 7) * 8;
    float acc[8];
#pragma unroll
    for (int e = 0; e < 8; ++e) acc[e] = 0.f;
    for (int j = 0; j < 64; ++j) {
      const float s = S[i * 65 + j];
      const f32x4 v0 = *(const f32x4*)(vs + j * 64 + dv0), v1 = *(const f32x4*)(vs + j * 64 + dv0 + 4);
      acc[0] += s * v0.x; acc[1] += s * v0.y; acc[2] += s * v0.z; acc[3] += s * v0.w; acc[4] += s * v1.x; acc[5] += s * v1.y; acc[6] += s * v1.z; acc[7] += s * v1.w;
    }
    for (int d = 0; d < 32; ++d) {
      const float a = qf[i * 33 + d], c = qb[i * 33 + d];
      const f32x4 f0 = *(const f32x4*)(spf + d * 64 + dv0), f1 = *(const f32x4*)(spf + d * 64 + dv0 + 4);
      const f32x4 b0 = *(const f32x4*)(spb + d * 64 + dv0), b1 = *(const f32x4*)(spb + d * 64 + dv0 + 4);
      acc[0] += a * f0.x + c * b0.x; acc[1] += a * f0.y + c * b0.y; acc[2] += a * f0.z + c * b0.z; acc[3] += a * f0.w + c * b0.w;
      acc[4] += a * f1.x + c * b1.x; acc[5] += a * f1.y + c * b1.y; acc[6] += a * f1.z + c * b1.z; acc[7] += a * f1.w + c * b1.w;
    }
    float ss = 0.f;
#pragma unroll
    for (int e = 0; e < 8; ++e) ss += acc[e] * acc[e];
    ss += __shfl_xor(ss, 1); ss += __shfl_xor(ss, 2); ss += __shfl_xor(ss, 4);
    const float rstd = rsqrtf(ss * (1.f / 64.f) + EPS);
    const int row = row0 + i;
    const float* g = p.out_norm_g + layer * 1024 + 768 + h * 64 + dv0;
    const float* gr = (const float*)(ws + OFF_GR) + (size_t)row * 256 + h * 64 + dv0;
    float o[8];
#pragma unroll
    for (int e = 0; e < 8; ++e) o[e] = acc[e] * rstd * g[e] * siluf(gr[e]);
    u32x4 w; w.x = pk2(o[0], o[1]); w.y = pk2(o[2], o[3]); w.z = pk2(o[4], o[5]); w.w = pk2(o[6], o[7]);
    *(u32x4*)((bf16_t*)(ws + OFF_U) + (size_t)row * 1024 + 768 + h * 64 + dv0) = w;
  }
}

__global__ void __launch_bounds__(NT) mk_fwd(Params p) {
  extern __shared__ __attribute__((aligned(16))) unsigned char lds[];
  __shared__ int s_item;
  cg::grid_group grid = cg::this_grid();
  int tid = threadIdx.x;
  unsigned char* ws = p.ws;
#define OPQ() asm volatile("" : "+v"(tid))
  if (PH & 1) phase0(p, lds, tid);
  grid.sync();
  for (int layer = 0; layer < 4; ++layer) {
    OPQ();
    if (PH & 2) spectra_items(p, layer, lds, tid);
    if (PH & 4) ctx_filters(p, layer, tid);
    if (PH & 8) weight_prep(p, layer, lds, tid);
    if (PH & 16) norm_rows(p, layer, 0, tid);
    grid.sync();
    OPQ();
    if (PH & 32) gemm_phase<0>(p, lds, (const bf16_t*)(ws + OFF_U), (const bf16_t*)(ws + OFF_WIN), 2432, 1024, layer, 0, tid);
    grid.sync();
    OPQ();
    {
      int* cnt = (int*)(ws + OFF_CNT) + layer;
      for (;;) {
        __syncthreads();
        if (tid == 0) s_item = atomicAdd(cnt, 1);
        __syncthreads();
        const int it = s_item;
        if (it >= 2096) break;
        if (!(PH & 64)) continue;
        OPQ();
        if (it < 512) { const int b = it >> 8, r = it & 255; attn_unit(p, lds, layer, b, r >> 5, b * 8192 + (r & 31) * 256, 0, NKEY, tid); }
        else if (it < 768) { const int i = it - 512; hyena_lat_item(p, lds, layer, i >> 7, i & 127, tid); }
        else if (it < 784) { const int i = it - 768, b = i >> 3; attn_unit(p, lds, layer, b, i & 7, 16384 + b * 256, 8192, 256, tid); }
        else if (it < 1040) { const int i = it - 784; hyena_ctx_item(p, lds, layer, i >> 7, i & 127, tid); }
        else { const int i = it - 1040, b = i / 528, r = i % 528; gla_local_item(p, lds, b, r >> 2, r & 3, tid); }
      }
    }
    grid.sync();
    OPQ();
    if (PH & 128) gla_scan(p, tid);
    if (PH & 256) for (int it = blockIdx.x; it < 264; it += gridDim.x) hyena_norm_item(p, lds, layer, it / 132, it % 132, tid);
    grid.sync();
    OPQ();
    if (PH & 512) for (int it = blockIdx.x; it < 1056; it += gridDim.x) { const int b = it / 528, r = it % 528; gla_out_item(p, lds, layer, b, r >> 2, r & 3, tid); }
    grid.sync();
    OPQ();
    if (PH & 1024) gemm_phase<1>(p, lds, (const bf16_t*)(ws + OFF_U), (const bf16_t*)(ws + OFF_WOUT), 1024, 1024, layer, 2048, tid);
    grid.sync();
    OPQ();
    if (PH & 16) norm_rows(p, layer, 1, tid);
    grid.sync();
    OPQ();
    if (PH & 2048) gemm_phase<2>(p, lds, (const bf16_t*)(ws + OFF_U), (const bf16_t*)(ws + OFF_W13), 5632, 1024, layer, 0, tid);
    grid.sync();
    OPQ();
    if (PH & 1024) gemm_phase<1>(p, lds, (const bf16_t*)(ws + OFF_HMID), (const bf16_t*)(ws + OFF_W2), 1024, 2816, layer, 5120, tid);
    grid.sync();
  }
  OPQ();
  {
    const int lane = tid & 63, gw = blockIdx.x * 8 + (tid >> 6), nw = gridDim.x * 8;
    const float* hres = (const float*)(ws + OFF_HRES);
    for (int row = gw; row < 16384; row += nw) {
      const f32x4* xr = (const f32x4*)(hres + (size_t)row * 1024) + lane;
      f32x4 v[4]; float s = 0.f;
#pragma unroll
      for (int j = 0; j < 4; ++j) { v[j] = xr[64 * j]; s += v[j].x * v[j].x + v[j].y * v[j].y + v[j].z * v[j].z + v[j].w * v[j].w; }
      const float rstd = rsqrtf(wave_sum(s) * (1.f / 1024.f) + EPS);
#pragma unroll
      for (int j = 0; j < 4; ++j) {
        const int col = lane * 4 + 256 * j;
        *(f32x4*)(p.out + (size_t)row * 1024 + col) = v[j] * rstd * *(const f32x4*)(p.final_norm_g + col);
      }
    }
  }
}

extern "C" void kernel_launch(void* const* d_in, const int* in_sizes, int n_in, void* d_out, int out_size, void* d_ws, size_t ws_size, hipStream_t stream) {
  static int grid_blocks = 0;
  if (!grid_blocks) {
    int dev = 0, cus = 0, per_cu = 0;
    hipGetDevice(&dev);
    hipDeviceGetAttribute(&cus, hipDeviceAttributeMultiprocessorCount, dev);
    hipFuncSetAttribute((const void*)mk_fwd, hipFuncAttributeMaxDynamicSharedMemorySize, LDS_BYTES);
    hipOccupancyMaxActiveBlocksPerMultiprocessor(&per_cu, (const void*)mk_fwd, NT, LDS_BYTES);
    if (per_cu < 1) per_cu = 1;
    grid_blocks = cus * per_cu;
    if (ws_size < WS_NEED || n_in != 28) { fprintf(stderr, "kernel_launch: ws_size %zu < %llu or n_in %d != 28\n", ws_size, (unsigned long long)WS_NEED, n_in); grid_blocks = -1; }
  }
  if (grid_blocks < 0) return;
  Params p{};
  const float** pp = (const float**)&p;
  for (int i = 0; i < 28; ++i) pp[i] = (const float*)d_in[i];
  p.out = (float*)d_out; p.ws = (unsigned char*)d_ws;
  void* args[] = {&p};
  hipError_t e = hipLaunchCooperativeKernel((const void*)mk_fwd, dim3(grid_blocks), dim3(NT), args, LDS_BYTES, stream);
  if (e != hipSuccess) fprintf(stderr, "cooperative launch failed: %s (grid %d)\n", hipGetErrorString(e), grid_blocks);
}
```

```cpp
#include <hip/hip_runtime.h>
#include <hip/hip_cooperative_groups.h>
#include <cstdio>
namespace cg = cooperative_groups;

typedef unsigned short bf16_t;
typedef short bf16x8 __attribute__((ext_vector_type(8)));
typedef short s16x4 __attribute__((ext_vector_type(4)));
typedef float f32x4 __attribute__((ext_vector_type(4)));
typedef float f32x16 __attribute__((ext_vector_type(16)));
typedef unsigned u32x4 __attribute__((ext_vector_type(4)));
typedef unsigned u32x2 __attribute__((ext_vector_type(2)));

#define NT 512
#ifndef PH
#define PH 0xffff
#endif
#ifndef REP3
#define REP3 1
#endif
#ifndef REPG
#define REPG 1
#endif
#define LDS_BYTES 143360
#define TOK 16896
#define DM 1024
#define NKEY 8448
#define FFH 2816
#define EPS 1e-6f

#define OFF_CNT 0ULL
#define OFF_MOD 4096ULL
#define OFF_ROPE 299008ULL
#define OFF_H2L 2396160ULL
#define OFF_H2C 10784768ULL
#define OFF_HC 11046912ULL
#define OFF_HRES 12095488ULL
#define OFF_U 81301504ULL
#define OFF_Q 115904512ULL
#define OFF_K 133206016ULL
#define OFF_VT 137531392ULL
#define OFF_WIN 141856768ULL
#define OFF_WOUT 147099648ULL
#define OFF_W13 149196800ULL
#define OFF_W2 160731136ULL
#define OFF_SPEC 166498304ULL
#define OFF_HYP 200056832ULL
#define OFF_GQ 226009088ULL
#define OFF_GK 234659840ULL
#define OFF_GV 243310592ULL
#define OFF_GR 260612096ULL
#define OFF_LR 277913600ULL
#define OFF_LGB 286564352ULL
#define OFF_HYRAW 295215104ULL
#define OFF_KV 312516608ULL
#define OFF_DEC 329818112ULL
#define OFF_HMID 200056832ULL
#define WS_NEED 330088448ULL

struct Params {
  const float *x, *c, *ctx, *c_ctx, *ada_w, *ada_b, *norm1_g, *w_in, *q_norm_g, *k_norm_g, *hy_conv_w, *hy_conv_b,
      *filt_w1, *filt_b1, *filt_w2, *filt_b2, *filt_w3, *filt_freq, *hy_bias, *gla_gate_w, *gla_gate_b, *out_norm_g,
      *w_out, *norm2_g, *ffn_w1, *ffn_w3, *ffn_w2, *final_norm_g;
  float* out;
  unsigned char* ws;
};

#define DI __device__ __forceinline__
DI bf16_t f2bf(float x) { unsigned u = __float_as_uint(x); u += 0x7fffu + ((u >> 16) & 1u); return (bf16_t)(u >> 16); }
DI unsigned pk2(float a, float b) { return (unsigned)f2bf(a) | ((unsigned)f2bf(b) << 16); }
DI float bf2f(bf16_t v) { return __uint_as_float(((unsigned)v) << 16); }
DI float wave_sum(float v) {
#pragma unroll
  for (int o = 1; o < 64; o <<= 1) v += __shfl_xor(v, o);
  return v;
}
DI float siluf(float x) { return x / (1.f + __expf(-x)); }
DI int row_mod(int row) { return row < 8192 ? 0 : (row < 16384 ? 1 : 2); }

DI void fft_fwd(float2* buf, int tid) {
#pragma unroll 1
  for (int m = 8192; m >= 1; m >>= 1) {
    const float inv2m = 0.5f / (float)m;
#pragma unroll 4
    for (int i = tid; i < 8192; i += NT) {
      const int j = i & (m - 1), i0 = ((i - j) << 1) + j, i1 = i0 + m;
      const float2 a = buf[i0], b = buf[i1];
      const float f = (float)j * inv2m;
      const float wr = __builtin_amdgcn_cosf(f), wi = -__builtin_amdgcn_sinf(f);
      const float dr = a.x - b.x, di = a.y - b.y;
      buf[i0] = make_float2(a.x + b.x, a.y + b.y);
      buf[i1] = make_float2(dr * wr - di * wi, dr * wi + di * wr);
    }
    __syncthreads();
  }
}
DI void fft_inv(float2* buf, int tid) {
#pragma unroll 1
  for (int m = 1; m < 16384; m <<= 1) {
    const float inv2m = 0.5f / (float)m;
#pragma unroll 4
    for (int i = tid; i < 8192; i += NT) {
      const int j = i & (m - 1), i0 = ((i - j) << 1) + j, i1 = i0 + m;
      const float2 a = buf[i0], b0 = buf[i1];
      const float f = (float)j * inv2m;
      const float wr = __builtin_amdgcn_cosf(f), wi = __builtin_amdgcn_sinf(f);
      const float br = b0.x * wr - b0.y * wi, bi = b0.x * wi + b0.y * wr;
      buf[i0] = make_float2(a.x + br, a.y + bi);
      buf[i1] = make_float2(a.x - br, a.y - bi);
    }
    __syncthreads();
  }
}
DI int brev14(int k) { return (int)(__brev((unsigned)k) >> 18); }

DI void spec_mul(float2* buf, const float4* spec, int tid) {
#pragma unroll 2
  for (int k = tid; k <= 8192; k += NT) {
    const int nk = (16384 - k) & 16383, rk = brev14(k), rnk = brev14(nk);
    const float2 zk = buf[rk], zn = buf[rnk];
    const float ar = 0.5f * (zk.x + zn.x), ai = 0.5f * (zk.y - zn.y);
    const float tr = zk.x - zn.x, ti = zk.y + zn.y;
    const float br = 0.5f * ti, bi = -0.5f * tr;
    const float4 h = spec[k];
    const float pr = ar * h.x - ai * h.y, pi = ar * h.y + ai * h.x;
    const float qr = br * h.z - bi * h.w, qi = br * h.w + bi * h.z;
    buf[rk] = make_float2(pr - qi, pi + qr);
    if (nk != k) buf[rnk] = make_float2(pr + qi, -pi + qr);
  }
  __syncthreads();
}

DI void phase0(const Params& p, unsigned char* lds, int tid) {
  unsigned char* ws = p.ws;
  const int G = gridDim.x, bid = blockIdx.x;
  if (bid == 0 && tid < 64) ((int*)(ws + OFF_CNT))[tid] = 0;
  {
    float4* h = (float4*)(ws + OFF_HRES);
    const float4* x = (const float4*)p.x; const float4* cx = (const float4*)p.ctx;
    const int nlat = 16384 * 256, nall = TOK * 256;
    for (int i = bid * NT + tid; i < nall; i += G * NT) h[i] = i < nlat ? x[i] : cx[i - nlat];
  }
  {
    float2* rt = (float2*)(ws + OFF_ROPE);
    for (int i = bid * NT + tid; i < 8192 * 32; i += G * NT) {
      const int pos = i >> 5, f = i & 31;
      const float invf = powf(10000.f, -(float)(f & 15) / 16.f);
      const float ang = (f < 16 ? (float)(pos >> 6) : (float)(pos & 63)) * invf;
      rt[i] = make_float2(cosf(ang), sinf(ang));
    }
  }
  float* lf = (float*)lds;
  for (int it = bid; it < 4 * 96; it += G) {
    const int l = it / 96, c0 = (it % 96) * 64, kg = tid >> 6, col = tid & 63;
    const float* w = p.ada_w + (size_t)l * 1024 * 6144 + c0 + col;
    float a0 = 0.f, a1 = 0.f, a2 = 0.f;
    for (int k = kg * 128; k < kg * 128 + 128; ++k) {
      const float wv = w[(size_t)k * 6144];
      a0 += siluf(p.c[k]) * wv; a1 += siluf(p.c[1024 + k]) * wv; a2 += siluf(p.c_ctx[k]) * wv;
    }
    lf[(kg * 3 + 0) * 64 + col] = a0; lf[(kg * 3 + 1) * 64 + col] = a1; lf[(kg * 3 + 2) * 64 + col] = a2;
    __syncthreads();
    if (tid < 192) {
      const int v = tid >> 6;
      float s = p.ada_b[l * 6144 + c0 + col];
      for (int g = 0; g < 8; ++g) s += lf[(g * 3 + v) * 64 + col];
      ((float*)(ws + OFF_MOD))[(l * 3 + v) * 6144 + c0 + col] = s;
    }
    __syncthreads();
  }
  for (int it = bid; it < 4 * (1024 + 32); it += G) {
    const int l = it / 1056, r = it % 1056, isctx = r >= 1024, n = isctx ? 256 : 8192, tile = isctx ? r - 1024 : r;
    const int ps = tid >> 6, j = tid & 63, pos = tile * 8 + ps;
    float* z = lf; float* h1 = lf + 8 * 33;
    if (j < 33) {
      float val;
      if (j == 0) val = (float)pos / (float)(n - 1);
      else {
        const int kb = (j - 1) & 15;
        const float band = 1e-4f + (float)kb * ((15.f - 1e-4f) / 15.f);
        const float omega = (float)(6.283185307179586 / (double)n) * (float)pos;
        const float ph = omega * band;
        val = (j <= 16) ? cosf(ph) : -sinf(ph);
      }
      z[ps * 33 + j] = val;
    }
    __syncthreads();
    const float fr = p.filt_freq[l * 64 + j];
    float a = p.filt_b1[l * 64 + j];
    for (int e = 0; e < 33; ++e) a += z[ps * 33 + e] * p.filt_w1[(l * 33 + e) * 64 + j];
    h1[ps * 64 + j] = sinf(fr * a);
    __syncthreads();
    float a2 = p.filt_b2[l * 64 + j];
    for (int i = 0; i < 64; ++i) a2 += h1[ps * 64 + i] * p.filt_w2[(l * 64 + i) * 64 + j];
    const float h2 = sinf(fr * a2);
    if (isctx) ((float*)(ws + OFF_H2C))[((size_t)l * 256 + pos) * 64 + j] = h2;
    else ((float*)(ws + OFF_H2L))[((size_t)l * 8192 + pos) * 64 + j] = h2;
    __syncthreads();
  }
}

DI float hy_delta(int c) {
  const float mn = -3.0701134573253944f, mx = -15.350567286626972f;
  return fabsf(mn + (float)c * ((mx - mn) / 255.f));
}

DI void norm_rows(const Params& p, int layer, int which  , int tid) {
  unsigned char* ws = p.ws;
  const int lane = tid & 63, gw = blockIdx.x * 8 + (tid >> 6), nw = gridDim.x * 8;
  const float* g = (which ? p.norm2_g : p.norm1_g) + layer * 1024;
  const float* hres = (const float*)(ws + OFF_HRES);
  bf16_t* u = (bf16_t*)(ws + OFF_U);
  for (int row = gw; row < TOK; row += nw) {
    const float* mod = (const float*)(ws + OFF_MOD) + (layer * 3 + row_mod(row)) * 6144 + which * 3072;
    const f32x4* xr = (const f32x4*)(hres + (size_t)row * 1024) + lane;
    f32x4 v[4]; float s = 0.f;
#pragma unroll
    for (int j = 0; j < 4; ++j) { v[j] = xr[64 * j]; s += v[j].x * v[j].x + v[j].y * v[j].y + v[j].z * v[j].z + v[j].w * v[j].w; }
    const float rstd = rsqrtf(wave_sum(s) * (1.f / 1024.f) + EPS);
#pragma unroll
    for (int j = 0; j < 4; ++j) {
      const int col = lane * 4 + 256 * j;
      const f32x4 gg = *(const f32x4*)(g + col), sh = *(const f32x4*)(mod + col), sc = *(const f32x4*)(mod + 1024 + col);
      const f32x4 o = (v[j] * rstd * gg) * (sc + 1.f) + sh;
      u32x2 w; w.x = pk2(o.x, o.y); w.y = pk2(o.z, o.w);
      *(u32x2*)(u + (size_t)row * 1024 + col) = w;
    }
  }
}

DI void wt_item(const float* W, const float* W2, int K, int N, bf16_t* WT, int mode, int kt, int nt, float* tile, int tid) {
  const int k0 = kt * 64, r0 = nt * 64;
  {
    const int r = r0 + (tid & 63);
    const float* src = W; int col = r;
    if (mode == 1) { col = (r >> 5) * 16 + (r & 15); if ((r >> 4) & 1) src = W2; }
    else if (mode == 3) {
      if (r < 2304) col = (r & ~255) + 64 * ((r >> 5) & 3) + 32 * ((r >> 4) & 1) + 16 * ((r >> 7) & 1) + (r & 15);
      else if (r >= 2336) col = -1;
    }
#pragma unroll
    for (int i = 0; i < 8; ++i) { const int k = i * 8 + (tid >> 6); tile[k * 65 + (tid & 63)] = col >= 0 ? src[(size_t)(k0 + k) * N + col] : 0.f; }
  }
  __syncthreads();
  {
    const int n = tid >> 3, kc = tid & 7;
    const float* sp = tile + (kc * 8) * 65 + n;
    u32x4 o; o.x = pk2(sp[0], sp[65]); o.y = pk2(sp[2 * 65], sp[3 * 65]); o.z = pk2(sp[4 * 65], sp[5 * 65]); o.w = pk2(sp[6 * 65], sp[7 * 65]);
    *(u32x4*)(WT + (size_t)(r0 + n) * K + k0 + kc * 8) = o;
  }
  __syncthreads();
}

DI void weight_prep(const Params& p, int layer, unsigned char* lds, int tid) {
  unsigned char* ws = p.ws; float* tile = (float*)lds;
  const int G = gridDim.x;
  const int I0 = 16 * 40, I1 = 16 * 16, I2 = 16 * 88, I3 = 44 * 16;
  for (int it = blockIdx.x; it < I0 + I1 + I2 + I3; it += G) {
    int r = it;
    if (r < I0) { wt_item(p.w_in + (size_t)layer * 1024 * 2336, nullptr, 1024, 2336, (bf16_t*)(ws + OFF_WIN), 3, r / 40, r % 40, tile, tid); continue; } r -= I0;
    if (r < I1) { wt_item(p.w_out + (size_t)layer * 1024 * 1024, nullptr, 1024, 1024, (bf16_t*)(ws + OFF_WOUT), 0, r / 16, r % 16, tile, tid); continue; } r -= I1;
    if (r < I2) { wt_item(p.ffn_w1 + (size_t)layer * 1024 * 2816, p.ffn_w3 + (size_t)layer * 1024 * 2816, 1024, 2816, (bf16_t*)(ws + OFF_W13), 1, r / 88, r % 88, tile, tid); continue; } r -= I2;
    wt_item(p.ffn_w2 + (size_t)layer * 2816 * 1024, nullptr, 2816, 1024, (bf16_t*)(ws + OFF_W2), 0, r / 16, r % 16, tile, tid);
  }
}

DI void ctx_filters(const Params& p, int layer, int tid) {
  unsigned char* ws = p.ws;
  const float* h2c = (const float*)(ws + OFF_H2C) + (size_t)layer * 256 * 64;
  float* hc = (float*)(ws + OFF_HC);
  for (int t = blockIdx.x; t < 256; t += gridDim.x) {
    const float tn = (float)t / 255.f;
#pragma unroll
    for (int cc = 0; cc < 2; ++cc) {
      const int col = tid + cc * 512;
      float a = 0.f;
      for (int j = 0; j < 64; ++j) a += h2c[t * 64 + j] * p.filt_w3[((size_t)layer * 64 + j) * 1024 + col];
      hc[t * 1024 + col] = a * __expf(-tn * hy_delta(col & 255));
    }
  }
}

DI void spectra_items(const Params& p, int layer, unsigned char* lds, int tid) {
  unsigned char* ws = p.ws;
  float2* buf = (float2*)lds;
  float* w3s = (float*)(lds + 131072);
  const float* h2l = (const float*)(ws + OFF_H2L) + (size_t)layer * 8192 * 64;
  for (int it = blockIdx.x; it < 256; it += gridDim.x) {
    const int o = it >> 7, pr = it & 127, ca = 2 * pr;
    if (tid < 256) {
      const int j = tid >> 2, q = tid & 3, sign = q >> 1, ch = ca + (q & 1);
      w3s[tid] = p.filt_w3[((size_t)layer * 64 + j) * 1024 + o * 512 + sign * 256 + ch];
    }
    __syncthreads();
    const float da = hy_delta(ca), db = hy_delta(ca + 1);
#pragma unroll 1
    for (int t = tid; t < 8192; t += NT) {
      const f32x4* hr = (const f32x4*)(h2l + (size_t)t * 64);
      float a0 = 0.f, a1 = 0.f, a2 = 0.f, a3 = 0.f;
#pragma unroll 1
      for (int jj = 0; jj < 16; ++jj) {
        const f32x4 hv = hr[jj];
#pragma unroll
        for (int e = 0; e < 4; ++e) {
          const float hvv = hv[e]; const f32x4 w = *(const f32x4*)(w3s + (jj * 4 + e) * 4);
          a0 += hvv * w.x; a1 += hvv * w.y; a2 += hvv * w.z; a3 += hvv * w.w;
        }
      }
      const float tn = (float)t / 8191.f, wa = __expf(-tn * da), wb = __expf(-tn * db);
      buf[t] = make_float2(a0 * wa, a1 * wb);
      if (t == 0) buf[8192] = make_float2(0.f, 0.f);
      else buf[16384 - t] = make_float2(a2 * wa, a3 * wb);
    }
    __syncthreads();
    fft_fwd(buf, tid);
    float4* spec = (float4*)(ws + OFF_SPEC) + (size_t)it * 8193;
#pragma unroll 2
    for (int k = tid; k <= 8192; k += NT) {
      const int nk = (16384 - k) & 16383;
      const float2 zk = buf[brev14(k)], zn = buf[brev14(nk)];
      const float tr = zk.x - zn.x, ti = zk.y + zn.y;
      spec[k] = make_float4(0.5f * (zk.x + zn.x), 0.5f * (zk.y - zn.y), 0.5f * ti, -0.5f * tr);
    }
    __syncthreads();
  }
}

#define MFMA16(a, b, c) __builtin_amdgcn_mfma_f32_16x16x32_bf16((a), (b), (c), 0, 0, 0)
#define MFMA32(a, b, c) __builtin_amdgcn_mfma_f32_32x32x16_bf16((a), (b), (c), 0, 0, 0)
#define LSA 72

DI float log_sigmoid(float z) { return fminf(z, 0.f) - log1pf(__expf(-fabsf(z))); }

DI void gemm_ctx(const Params& p, unsigned char* lds, const bf16_t* A, const bf16_t* Bt, int N, int K, int layer, int goff, int tm0, int ntm, int tid) {
  constexpr int EPI = 1;
  unsigned char* ws = p.ws;
  const int lane = tid & 63, wave = tid >> 6, wm = wave >> 1, wn = wave & 1, fr = lane & 15, fq = lane >> 4;
  const int tilesN = N / 128, ntiles = ntm * tilesN, nk = K / 64;
  bf16_t* As = (bf16_t*)lds;
  bf16_t* Bs = (bf16_t*)(lds + 73728);
  for (int tile = blockIdx.x; tile < ntiles; tile += gridDim.x) {
    const int tm = tm0 + tile / tilesN, tn = tile % tilesN;
    const bf16_t* Ag = A + (size_t)(tm * 256) * K;
    const bf16_t* Bg = Bt + (size_t)(tn * 128) * K;
    f32x4 acc[4][4];
#pragma unroll
    for (int m = 0; m < 4; ++m)
#pragma unroll
      for (int n = 0; n < 4; ++n) acc[m][n] = (f32x4){0.f, 0.f, 0.f, 0.f};
    u32x4 ra[4], rb[2];
#pragma unroll
    for (int i = 0; i < 4; ++i) { const int c = tid + NT * i; ra[i] = *(const u32x4*)(Ag + (size_t)(c >> 3) * K + (c & 7) * 8); }
#pragma unroll
    for (int i = 0; i < 2; ++i) { const int c = tid + NT * i; rb[i] = *(const u32x4*)(Bg + (size_t)(c >> 3) * K + (c & 7) * 8); }
#pragma unroll
    for (int i = 0; i < 4; ++i) { const int c = tid + NT * i; *(u32x4*)(As + (c >> 3) * LSA + (c & 7) * 8) = ra[i]; }
#pragma unroll
    for (int i = 0; i < 2; ++i) { const int c = tid + NT * i; *(u32x4*)(Bs + (c >> 3) * LSA + (c & 7) * 8) = rb[i]; }
    __syncthreads();
    for (int kt = 0; kt < nk; ++kt) {
      const int cur = kt & 1;
      if (kt + 1 < nk) {
        const int k0 = (kt + 1) * 64;
#pragma unroll
        for (int i = 0; i < 4; ++i) { const int c = tid + NT * i; ra[i] = *(const u32x4*)(Ag + (size_t)(c >> 3) * K + k0 + (c & 7) * 8); }
#pragma unroll
        for (int i = 0; i < 2; ++i) { const int c = tid + NT * i; rb[i] = *(const u32x4*)(Bg + (size_t)(c >> 3) * K + k0 + (c & 7) * 8); }
      }
      const bf16_t* as = As + cur * (256 * LSA) + (wm * 64 + fr) * LSA + fq * 8;
      const bf16_t* bs = Bs + cur * (128 * LSA) + (wn * 64 + fr) * LSA + fq * 8;
#pragma unroll
      for (int ks = 0; ks < 2; ++ks) {
        bf16x8 af[4], bfr[4];
#pragma unroll
        for (int m = 0; m < 4; ++m) af[m] = *(const bf16x8*)(as + m * 16 * LSA + ks * 32);
#pragma unroll
        for (int n = 0; n < 4; ++n) bfr[n] = *(const bf16x8*)(bs + n * 16 * LSA + ks * 32);
#pragma unroll
        for (int m = 0; m < 4; ++m)
#pragma unroll
          for (int n = 0; n < 4; ++n) acc[m][n] = MFMA16(bfr[n], af[m], acc[m][n]);
      }
      if (kt + 1 < nk) {
        const int nb = cur ^ 1;
#pragma unroll
        for (int i = 0; i < 4; ++i) { const int c = tid + NT * i; *(u32x4*)(As + nb * (256 * LSA) + (c >> 3) * LSA + (c & 7) * 8) = ra[i]; }
#pragma unroll
        for (int i = 0; i < 2; ++i) { const int c = tid + NT * i; *(u32x4*)(Bs + nb * (128 * LSA) + (c >> 3) * LSA + (c & 7) * 8) = rb[i]; }
      }
      __syncthreads();
    }
    const int row0 = tm * 256 + wm * 64, col0 = tn * 128 + wn * 64;
    {
      float* hres = (float*)(ws + OFF_HRES);
      const float* gm = (const float*)(ws + OFF_MOD) + (layer * 3 + row_mod(row0)) * 6144 + goff;
#pragma unroll
      for (int m = 0; m < 4; ++m)
#pragma unroll
        for (int n = 0; n < 4; ++n) {
          const int row = row0 + m * 16 + fr, col = col0 + n * 16 + fq * 4;
          f32x4* hp = (f32x4*)(hres + (size_t)row * 1024 + col);
          const f32x4 g = *(const f32x4*)(gm + col);
          *hp = *hp + g * acc[m][n];
        }
    }
  }
}

namespace pg8 {
#define PG8_LAS __attribute__((address_space(3)))
using ::bf16_t; using ::bf16x8; using ::f32x4; using ::u32x4;
constexpr int BM = 256, BK = 64, HALF = 128, HTB = HALF * BK * 2  , STAGE_BYTES = 8 * HTB, NXCD = 8, WGM = 8;

__host__ __device__ __forceinline__ int lds_byte(int r, int c) { const int st = (r >> 4) * 2 + (c >> 5), rr = r & 15, cc = c & 31, ob = rr * 64 + cc * 2; return st * 1024 + (ob ^ (((ob >> 9) & 1) << 5)); }
__host__ __device__ __forceinline__ void stage_rc(int b, int& R, int& C) { const int st = b / 1024, sb = b % 1024, swz = sb ^ (((sb >> 9) & 1) << 5); R = (st >> 1) * 16 + swz / 64; C = (st & 1) * 32 + (swz % 64) / 2; }
__host__ __device__ __forceinline__ int perm32(int rho) { const int n = rho >> 4, i = rho & 15; return 8 * (i >> 2) + 4 * n + (i & 3); }

struct Unit { int pm, pn; };
struct Gemm { const bf16_t* A; const bf16_t* Bt; int M, N, K; };

struct StaticOrder {
    int nM, nN, nwg, G, c;
    __host__ __device__ void init(int M, int N, int G_, int c_) { nM = M / BM; nN = N / BM; nwg = nM * nN; G = G_; c = c_; }
    __host__ __device__ bool next(int i, Unit& u) const {
        const long L = (long)i * G + c; if (L >= nwg) return false;
        int wgid = (int)L; { const int q = nwg / NXCD, r = nwg % NXCD, xcd = wgid % NXCD, off = wgid / NXCD; wgid = (xcd < r ? xcd * (q + 1) : r * (q + 1) + (xcd - r) * q) + off; }
        const int nig = WGM * nN, gid = wgid / nig, fm = gid * WGM, gsz = (nM - fm) < WGM ? (nM - fm) : WGM;
        u.pm = fm + ((wgid % nig) % gsz); u.pn = (wgid % nig) / gsz; return true;
    }
    __device__ __forceinline__ void a_ready(const Unit&) const {}
    __device__ __forceinline__ void done(const Unit&) const {}
};

template <class Epi, class Sched, bool ALIGN_EPI = false, bool SP2 = false>
__device__ __forceinline__ void gemm_phase(PG8_LAS unsigned char* lds, const Gemm g, const Sched& S, const Epi& E, const int tid) {
    const int wid = __builtin_amdgcn_readfirstlane(tid >> 6), lane = tid & 63, wr = wid >> 2, wc = wid & 3, fr = lane & 15, fq = lane >> 4;
    const int K = g.K, nt = K / BK;
    unsigned voffA[2], voffB[2];
#pragma unroll
    for (int i = 0; i < 2; ++i) { int R, C; stage_rc(tid * 16 + i * 8192, R, C); const int Rb = Epi::PERM ? ((R & ~31) + perm32(R & 31)) : R;
        voffA[i] = (unsigned)(R * K + C) * 2u; voffB[i] = (unsigned)(Rb * K + C) * 2u; }
    const size_t kstep = (size_t)(BK * 2);
    const size_t hstep = (size_t)HALF * K * 2;
    const size_t tstep = 2 * hstep;
    const unsigned ldsw = (unsigned)wid * 1024u;
    const int aoff = lds_byte(wr * 64 + fr, fq * 8), boff = lds_byte(wc * 32 + fr, fq * 8);
#define PG8_SA(b, h) (((b) * 2 + (h)) * HTB)
#define PG8_SB(b, h) ((4 + (b) * 2 + (h)) * HTB)
#define PG8_STAGE(bufoff, gbase, voff) do { _Pragma("unroll") for (int _i = 0; _i < 2; ++_i) \
        __builtin_amdgcn_global_load_lds((const unsigned*)((const char*)(gbase) + (voff)[_i]), (PG8_LAS unsigned*)(lds + (bufoff) + ldsw + _i * 8192), 16, 0, 0); } while (0)
#define PG8_LDA(dst, b, h) do { _Pragma("unroll") for (int m = 0; m < 4; ++m) _Pragma("unroll") for (int k = 0; k < 2; ++k) dst[m][k] = *(const PG8_LAS bf16x8*)(lds + PG8_SA(b, h) + aoff + m * 2048 + k * 1024); } while (0)
#define PG8_LDB(dst, b, h) do { _Pragma("unroll") for (int n = 0; n < 2; ++n) _Pragma("unroll") for (int k = 0; k < 2; ++k) dst[n][k] = *(const PG8_LAS bf16x8*)(lds + PG8_SB(b, h) + boff + n * 2048 + k * 1024); } while (0)
#define PG8_MMA(ai, bj, At, Bt) do { __builtin_amdgcn_s_setprio(1); _Pragma("unroll") for (int m = 0; m < 4; ++m) _Pragma("unroll") for (int n = 0; n < 2; ++n) _Pragma("unroll") for (int k = 0; k < 2; ++k) \
        acc[ai][bj][m][n] = __builtin_amdgcn_mfma_f32_16x16x32_bf16(Bt[n][k], At[m][k], acc[ai][bj][m][n], 0, 0, 0); __builtin_amdgcn_s_setprio(0); } while (0)
#define PG8_WAIT_V(n) asm volatile("s_waitcnt vmcnt(" #n ")" ::: "memory")
#define PG8_WAIT_L(n) asm volatile("s_waitcnt lgkmcnt(" #n ")" ::: "memory")
#define PG8_BAR __builtin_amdgcn_s_barrier()
#define PG8_SCHED __builtin_amdgcn_sched_barrier(0)
    Unit cur, nxt; int ui = 0;
    if (!S.next(0, cur)) return;
    f32x4 acc[2][2][4][2];
#pragma unroll
    for (int a = 0; a < 2; ++a)
#pragma unroll
        for (int b = 0; b < 2; ++b)
#pragma unroll
            for (int m = 0; m < 4; ++m)
#pragma unroll
                for (int n = 0; n < 2; ++n) acc[a][b][m][n] = (f32x4){0.f, 0.f, 0.f, 0.f};
    bf16x8 At[4][2], B0[2][2], B1[2][2];
    const char* cA = (const char*)g.A + (size_t)cur.pm * tstep; const char* cB = (const char*)g.Bt + (size_t)cur.pn * tstep;
    S.a_ready(cur);
    if constexpr (SP2) {
        PG8_STAGE(PG8_SB(0, 0), cB, voffB); PG8_STAGE(PG8_SB(0, 1), cB + hstep, voffB); PG8_STAGE(PG8_SA(0, 0), cA, voffA); PG8_STAGE(PG8_SA(0, 1), cA + hstep, voffA);
        if (wr == 1) PG8_BAR;
        PG8_WAIT_V(2); PG8_BAR;
        PG8_STAGE(PG8_SB(1, 0), cB + kstep, voffB); PG8_STAGE(PG8_SA(1, 0), cA + kstep, voffA); PG8_STAGE(PG8_SB(1, 1), cB + hstep + kstep, voffB);
        PG8_WAIT_V(6); PG8_BAR;
    } else {
        PG8_STAGE(PG8_SB(0, 0), cB, voffB); PG8_STAGE(PG8_SA(0, 0), cA, voffA); PG8_STAGE(PG8_SB(0, 1), cB + hstep, voffB); PG8_STAGE(PG8_SA(0, 1), cA + hstep, voffA);
        if (wr == 1) PG8_BAR;
        PG8_WAIT_V(4); PG8_BAR;
        PG8_STAGE(PG8_SB(1, 0), cB + kstep, voffB); PG8_STAGE(PG8_SA(1, 0), cA + kstep, voffA); PG8_STAGE(PG8_SB(1, 1), cB + hstep + kstep, voffB);
        PG8_WAIT_V(6); PG8_BAR;
    }
    for (;;) {
        const bool has_next = S.next(ui + 1, nxt);
        const char* nA = has_next ? (const char*)g.A + (size_t)nxt.pm * tstep : cA; const char* nB = has_next ? (const char*)g.Bt + (size_t)nxt.pn * tstep : cB;
        for (int t = 0; t < nt; t += 2) {
            const bool last = (t == nt - 2);
            const char* a1 = cA + (size_t)(t + 1) * kstep;
            const char* a2 = last ? nA : cA + (size_t)(t + 2) * kstep; const char* b2 = last ? nB : cB + (size_t)(t + 2) * kstep;
            const char* a3 = a2 + kstep; const char* b3 = b2 + kstep;
            if (last && has_next) S.a_ready(nxt);
            if constexpr (SP2) {
            PG8_LDB(B0, 0, 0); PG8_LDB(B1, 0, 1); PG8_SCHED; PG8_LDA(At, 0, 0); PG8_STAGE(PG8_SA(1, 1), a1 + hstep, voffA);
            PG8_WAIT_V(8); PG8_WAIT_L(0); PG8_BAR; PG8_MMA(0, 0, At, B0); PG8_MMA(0, 1, At, B1); PG8_BAR; PG8_SCHED;
            PG8_LDA(At, 0, 1); PG8_STAGE(PG8_SB(0, 0), b2, voffB); PG8_STAGE(PG8_SB(0, 1), b2 + hstep, voffB); PG8_STAGE(PG8_SA(0, 0), a2, voffA);
            PG8_WAIT_V(8); PG8_WAIT_L(0); PG8_BAR; PG8_MMA(1, 0, At, B0); PG8_MMA(1, 1, At, B1); PG8_BAR; PG8_SCHED;
            PG8_LDB(B0, 1, 0); PG8_LDB(B1, 1, 1); PG8_SCHED; PG8_LDA(At, 1, 0); PG8_STAGE(PG8_SA(0, 1), a2 + hstep, voffA);
            PG8_WAIT_V(8); PG8_WAIT_L(0); PG8_BAR; PG8_MMA(0, 0, At, B0); PG8_MMA(0, 1, At, B1); PG8_BAR; PG8_SCHED;
            PG8_LDA(At, 1, 1); PG8_STAGE(PG8_SB(1, 0), b3, voffB); PG8_STAGE(PG8_SB(1, 1), b3 + hstep, voffB); PG8_STAGE(PG8_SA(1, 0), a3, voffA);
            PG8_WAIT_V(8); PG8_WAIT_L(0); PG8_BAR; PG8_MMA(1, 0, At, B0); PG8_MMA(1, 1, At, B1); PG8_BAR; PG8_SCHED;
            } else {
            PG8_LDB(B0, 0, 0); PG8_SCHED; PG8_LDA(At, 0, 0); PG8_STAGE(PG8_SA(1, 1), a1 + hstep, voffA);
            PG8_WAIT_L(8); PG8_BAR; PG8_WAIT_L(0); PG8_MMA(0, 0, At, B0); PG8_BAR; PG8_SCHED;
            PG8_LDB(B1, 0, 1); PG8_STAGE(PG8_SB(0, 0), b2, voffB);
            PG8_BAR; PG8_WAIT_L(0); PG8_MMA(0, 1, At, B1); PG8_BAR;
            PG8_LDA(At, 0, 1); PG8_STAGE(PG8_SA(0, 0), a2, voffA);
            PG8_BAR; PG8_WAIT_L(0); PG8_MMA(1, 0, At, B0); PG8_BAR; PG8_SCHED;
            PG8_STAGE(PG8_SB(0, 1), b2 + hstep, voffB);
            PG8_WAIT_V(6); PG8_BAR; PG8_MMA(1, 1, At, B1); PG8_BAR;
            PG8_LDB(B0, 1, 0); PG8_SCHED; PG8_LDA(At, 1, 0); PG8_STAGE(PG8_SA(0, 1), a2 + hstep, voffA);
            PG8_WAIT_L(8); PG8_BAR; PG8_WAIT_L(0); PG8_MMA(0, 0, At, B0); PG8_BAR; PG8_SCHED;
            PG8_LDB(B1, 1, 1); PG8_STAGE(PG8_SB(1, 0), b3, voffB);
            PG8_BAR; PG8_WAIT_L(0); PG8_MMA(0, 1, At, B1); PG8_BAR;
            PG8_LDA(At, 1, 1); PG8_STAGE(PG8_SA(1, 0), a3, voffA);
            PG8_BAR; PG8_WAIT_L(0); PG8_MMA(1, 0, At, B0); PG8_BAR; PG8_SCHED;
            PG8_STAGE(PG8_SB(1, 1), b3 + hstep, voffB);
            PG8_WAIT_V(6); PG8_BAR; PG8_MMA(1, 1, At, B1); PG8_BAR;
            }
        }
        if constexpr (ALIGN_EPI) { if (wr == 0) PG8_BAR; }
        if constexpr (!Epi::AFTER_DRAIN) { E(acc, cur, wr, wc, fr, fq); S.done(cur); }
        if (!has_next) break;
#pragma unroll
        for (int a = 0; a < 2; ++a)
#pragma unroll
            for (int b = 0; b < 2; ++b)
#pragma unroll
                for (int m = 0; m < 4; ++m)
#pragma unroll
                    for (int n = 0; n < 2; ++n) acc[a][b][m][n] = (f32x4){0.f, 0.f, 0.f, 0.f};
        cur = nxt; cA = nA; cB = nB; ++ui;
        if constexpr (ALIGN_EPI) { if (wr == 1) PG8_BAR; }
    }
    PG8_WAIT_V(0);
    if constexpr (!ALIGN_EPI) { if (wr == 0) PG8_BAR; }
    PG8_BAR;
    if constexpr (Epi::AFTER_DRAIN) { E.fused(acc, cur, wr, wc, fr, fq, lds, wid, lane); S.done(cur); }
#undef PG8_SA
#undef PG8_SB
#undef PG8_STAGE
#undef PG8_LDA
#undef PG8_LDB
#undef PG8_MMA
#undef PG8_WAIT_V
#undef PG8_WAIT_L
#undef PG8_BAR
#undef PG8_SCHED
}
}


struct EpiResid {
  static constexpr bool PERM = false, AFTER_DRAIN = false;
  float* hres; const float* modl; int goff;
  __device__ __forceinline__ void operator()(const f32x4 (&acc)[2][2][4][2], const pg8::Unit& u, int wr, int wc, int fr_, int fq_) const {
    int fr = fr_, fq = fq_; asm volatile("" : "+v"(fr), "+v"(fq));
    const int row0 = u.pm * 256 + wr * 64 + fr, col0 = u.pn * 256 + wc * 32 + 4 * fq;
    const float* gm = modl + (u.pm < 32 ? 0 : (u.pm < 64 ? 1 : 2)) * 6144 + goff;
#pragma unroll
    for (int bj = 0; bj < 2; ++bj)
#pragma unroll
      for (int n = 0; n < 2; ++n) {
        const int col = col0 + bj * 128 + n * 16;
        const f32x4 g = *(const f32x4*)(gm + col);
#pragma unroll
        for (int ai = 0; ai < 2; ++ai)
#pragma unroll
          for (int m = 0; m < 4; ++m) {
            f32x4* hp = (f32x4*)(hres + (size_t)(row0 + ai * 128 + m * 16) * 1024 + col);
            *hp = *hp + g * acc[ai][bj][m][n];
          }
        asm volatile("" ::: "memory");
      }
  }
};
struct EpiSwiglu {
  static constexpr bool PERM = false, AFTER_DRAIN = false;
  bf16_t* hm;
  __device__ __forceinline__ void operator()(const f32x4 (&acc)[2][2][4][2], const pg8::Unit& u, int wr, int wc, int fr_, int fq_) const {
    int fr = fr_, fq = fq_; asm volatile("" : "+v"(fr), "+v"(fq));
    const int row0 = u.pm * 256 + wr * 64 + fr, hid0 = u.pn * 128 + wc * 16 + 4 * fq;
#pragma unroll
    for (int ai = 0; ai < 2; ++ai)
#pragma unroll
      for (int m = 0; m < 4; ++m)
#pragma unroll
        for (int bj = 0; bj < 2; ++bj) {
          const f32x4 a = acc[ai][bj][m][0], g = acc[ai][bj][m][1];
          u32x2 w; w.x = pk2(siluf(a.x) * g.x, siluf(a.y) * g.y); w.y = pk2(siluf(a.z) * g.z, siluf(a.w) * g.w);
          *(u32x2*)(hm + (size_t)(row0 + ai * 128 + m * 16) * FFH + hid0 + bj * 64) = w;
        }
  }
};
struct EpiInproj {
  static constexpr bool PERM = false, AFTER_DRAIN = false;
  unsigned char* ws; const float *qg, *kg;
  __device__ __forceinline__ void operator()(const f32x4 (&acc)[2][2][4][2], const pg8::Unit& u, int wr, int wc, int fr_, int fq_) const {
    int fr = fr_, fq = fq_; asm volatile("" : "+v"(fr), "+v"(fq));
    const int pn = u.pn, pm = u.pm;
    const bool isctx = pm >= 64;
    const int b = isctx ? pm - 64 : pm >> 5;
    const int rowb = pm * 256 + wr * 64 + fr;
#ifndef EB
#define EB 15
#endif
    if ((EB & 1) && (pn < 2 || (pn == 2 && wc < 2))) {
      const bool isq = pn < 2;
      const float* g = isq ? qg : kg;
      const float sc = isq ? 0.125f * 1.4426950408889634f : 1.f;
#pragma unroll
      for (int ai = 0; ai < 2; ++ai)
#pragma unroll
        for (int m = 0; m < 4; ++m) {
          const int row = rowb + ai * 128 + m * 16;
          float ss = 0.f;
#pragma unroll
          for (int bj = 0; bj < 2; ++bj)
#pragma unroll
            for (int n = 0; n < 2; ++n) { const f32x4 x = acc[ai][bj][m][n]; ss += x.x * x.x + x.y * x.y + x.z * x.z + x.w * x.w; }
          ss += __shfl_xor(ss, 16); ss += __shfl_xor(ss, 32);
          const float rstd = rsqrtf(ss * (1.f / 64.f) + EPS);
          const int pos = isctx ? (row & 255) : (row & 8191), tok = isctx ? 8192 + pos : pos;
          bf16_t* dst = isq ? (bf16_t*)(ws + OFF_Q) + (size_t)row * 512 + (pn * 4 + wc) * 64 : (bf16_t*)(ws + OFF_K) + ((size_t)(b * 2 + wc) * NKEY + tok) * 64;
#pragma unroll
          for (int bj = 0; bj < 2; ++bj) {
            const int d0 = 16 * bj + 4 * fq;
            f32x4 x0 = acc[ai][bj][m][0] * rstd * *(const f32x4*)(g + d0), x1 = acc[ai][bj][m][1] * rstd * *(const f32x4*)(g + 32 + d0);
            if (!isctx) {
              const f32x4* rt = (const f32x4*)((const float2*)(ws + OFF_ROPE) + (size_t)pos * 32 + d0);
              const f32x4 cs0 = rt[0], cs1 = rt[1];
              const f32x4 c = (f32x4){cs0.x, cs0.z, cs1.x, cs1.z}, sn = (f32x4){cs0.y, cs0.w, cs1.y, cs1.w};
              const f32x4 y0 = x0 * c - x1 * sn, y1 = x0 * sn + x1 * c;
              x0 = y0; x1 = y1;
            }
            x0 = x0 * sc; x1 = x1 * sc;
            u32x2 w0, w1; w0.x = pk2(x0.x, x0.y); w0.y = pk2(x0.z, x0.w); w1.x = pk2(x1.x, x1.y); w1.y = pk2(x1.z, x1.w);
            *(u32x2*)(dst + d0) = w0; *(u32x2*)(dst + 32 + d0) = w1;
          }
        }
    } else if ((EB & 2) && pn < 6) {
      bf16_t* base = pn == 2 ? (bf16_t*)(ws + OFF_VT) + ((size_t)(b * 2 + (wc - 2)) * 64) * NKEY : (bf16_t*)(ws + OFF_HYP) + ((size_t)b * 768 + (pn - 3) * 256 + wc * 64) * NKEY;
#pragma unroll
      for (int ai = 0; ai < 2; ++ai)
#pragma unroll
        for (int m = 0; m < 4; ++m) {
          const int row = rowb + ai * 128 + m * 16;
          const int tok = isctx ? 8192 + (row & 255) : (row & 8191);
#pragma unroll
          for (int bj = 0; bj < 2; ++bj)
#pragma unroll
            for (int n = 0; n < 2; ++n) {
              const f32x4 x = acc[ai][bj][m][n];
              bf16_t* dp = base + (size_t)(32 * n + 16 * bj + 4 * fq) * NKEY + tok;
              dp[0] = f2bf(x.x); dp[NKEY] = f2bf(x.y); dp[2 * NKEY] = f2bf(x.z); dp[3 * NKEY] = f2bf(x.w);
              asm volatile("" ::: "memory");
            }
        }
    } else if ((EB & 4) && pn < 9) {
      float* base; int ld; float sc = 1.f;
      if (pn == 6) { ld = 128; if (wc < 2) { base = (float*)(ws + OFF_GQ) + wc * 64; sc = 0.17677669529663687f; } else base = (float*)(ws + OFF_GK) + (wc - 2) * 64; }
      else { ld = 256; base = (float*)(ws + (pn == 7 ? OFF_GV : OFF_GR)) + wc * 64; }
#pragma unroll
      for (int ai = 0; ai < 2; ++ai)
#pragma unroll
        for (int m = 0; m < 4; ++m) {
          const int row = rowb + ai * 128 + m * 16;
#pragma unroll
          for (int bj = 0; bj < 2; ++bj)
#pragma unroll
            for (int n = 0; n < 2; ++n) *(f32x4*)(base + (size_t)row * ld + 32 * n + 16 * bj + 4 * fq) = acc[ai][bj][m][n] * sc;
          asm volatile("" ::: "memory");
        }
    } else if (wc == 0) {
      float* base = (float*)(ws + OFF_LR) + 4 * fq;
#pragma unroll
      for (int ai = 0; ai < 2; ++ai)
#pragma unroll
        for (int m = 0; m < 4; ++m) {
          const int row = rowb + ai * 128 + m * 16;
          *(f32x4*)(base + (size_t)row * 32) = acc[ai][0][m][0]; *(f32x4*)(base + (size_t)row * 32 + 16) = acc[ai][0][m][1];
        }
    }
  }
};

DI void attn_unit(const Params& p, unsigned char* lds, int layer, int b, int head, int qrow0, int key0, int nkeys, int tid) {
  unsigned char* ws = p.ws;
  const int lane = tid & 63, wave = tid >> 6, l31 = lane & 31, h = lane >> 5, kvh = head >> 2;
  const bf16_t* Kg = (const bf16_t*)(ws + OFF_K) + ((size_t)(b * 2 + kvh) * NKEY + key0) * 64;
  const bf16_t* Vg = (const bf16_t*)(ws + OFF_VT) + ((size_t)(b * 2 + kvh) * 64) * NKEY + key0;
  bf16_t* Ks = (bf16_t*)lds;
  bf16_t* Vs = (bf16_t*)(lds + 18432);
  const int qrow = qrow0 + wave * 32 + l31;
  bf16x8 qf[4];
#pragma unroll
  for (int s = 0; s < 4; ++s) qf[s] = *(const bf16x8*)((const bf16_t*)(ws + OFF_Q) + (size_t)qrow * 512 + head * 64 + 16 * s + 8 * h);
  f32x16 o0, o1;
#pragma unroll
  for (int i = 0; i < 16; ++i) { o0[i] = 0.f; o1[i] = 0.f; }
  float mrun = -1e30f, lsum = 0.f;
  const int ntile = nkeys >> 6, lr = tid >> 3, lc = tid & 7;
  u32x4 rk = *(const u32x4*)(Kg + (size_t)lr * 64 + lc * 8);
  u32x4 rv = *(const u32x4*)(Vg + (size_t)lr * NKEY + lc * 8);
  __syncthreads();
  *(u32x4*)(Ks + lr * 72 + lc * 8) = rk;
  *(u32x2*)(Vs + lr * 68 + lc * 8) = (u32x2){rv.x, rv.y};
  *(u32x2*)(Vs + lr * 68 + lc * 8 + 4) = (u32x2){rv.z, rv.w};
  __syncthreads();
  for (int t = 0; t < ntile; ++t) {
    const int cur = t & 1;
    if (t + 1 < ntile) {
      rk = *(const u32x4*)(Kg + (size_t)((t + 1) * 64 + lr) * 64 + lc * 8);
      rv = *(const u32x4*)(Vg + (size_t)lr * NKEY + (t + 1) * 64 + lc * 8);
    }
    const bf16_t* ks = Ks + cur * (64 * 72);
    const bf16_t* vs = Vs + cur * (64 * 68);
    f32x16 s0, s1;
#pragma unroll
    for (int i = 0; i < 16; ++i) { s0[i] = 0.f; s1[i] = 0.f; }
#pragma unroll
    for (int s = 0; s < 4; ++s) {
      const bf16x8 a0 = *(const bf16x8*)(ks + l31 * 72 + 16 * s + 8 * h);
      const bf16x8 a1 = *(const bf16x8*)(ks + (32 + l31) * 72 + 16 * s + 8 * h);
      s0 = MFMA32(a0, qf[s], s0); s1 = MFMA32(a1, qf[s], s1);
    }
    float mx = s0[0];
#pragma unroll
    for (int i = 1; i < 16; ++i) mx = fmaxf(mx, s0[i]);
#pragma unroll
    for (int i = 0; i < 16; ++i) mx = fmaxf(mx, s1[i]);
    mx = fmaxf(mx, __shfl_xor(mx, 32));
    const float mnew = fmaxf(mrun, mx), alpha = __builtin_amdgcn_exp2f(mrun - mnew);
    mrun = mnew;
    float ps = 0.f;
#pragma unroll
    for (int i = 0; i < 16; ++i) { s0[i] = __builtin_amdgcn_exp2f(s0[i] - mnew); s1[i] = __builtin_amdgcn_exp2f(s1[i] - mnew); ps += s0[i] + s1[i]; }
    lsum = lsum * alpha + ps;
#pragma unroll
    for (int i = 0; i < 16; ++i) { o0[i] *= alpha; o1[i] *= alpha; }
#pragma unroll
    for (int kk = 0; kk < 4; ++kk) {
      u32x4 pw;
      if (kk == 0) { pw.x = pk2(s0[0], s0[1]); pw.y = pk2(s0[2], s0[3]); pw.z = pk2(s0[4], s0[5]); pw.w = pk2(s0[6], s0[7]); }
      else if (kk == 1) { pw.x = pk2(s0[8], s0[9]); pw.y = pk2(s0[10], s0[11]); pw.z = pk2(s0[12], s0[13]); pw.w = pk2(s0[14], s0[15]); }
      else if (kk == 2) { pw.x = pk2(s1[0], s1[1]); pw.y = pk2(s1[2], s1[3]); pw.z = pk2(s1[4], s1[5]); pw.w = pk2(s1[6], s1[7]); }
      else { pw.x = pk2(s1[8], s1[9]); pw.y = pk2(s1[10], s1[11]); pw.z = pk2(s1[12], s1[13]); pw.w = pk2(s1[14], s1[15]); }
      const bf16x8 pf = __builtin_bit_cast(bf16x8, pw);
      const int kb = 16 * kk + 4 * h;
      {
        const s16x4 lo = *(const s16x4*)(vs + l31 * 68 + kb), hi = *(const s16x4*)(vs + l31 * 68 + kb + 8);
        o0 = MFMA32(__builtin_shufflevector(lo, hi, 0, 1, 2, 3, 4, 5, 6, 7), pf, o0);
      }
      {
        const s16x4 lo = *(const s16x4*)(vs + (32 + l31) * 68 + kb), hi = *(const s16x4*)(vs + (32 + l31) * 68 + kb + 8);
        o1 = MFMA32(__builtin_shufflevector(lo, hi, 0, 1, 2, 3, 4, 5, 6, 7), pf, o1);
      }
    }
    if (t + 1 < ntile) {
      const int nb = cur ^ 1;
      *(u32x4*)(Ks + nb * (64 * 72) + lr * 72 + lc * 8) = rk;
      *(u32x2*)(Vs + nb * (64 * 68) + lr * 68 + lc * 8) = (u32x2){rv.x, rv.y};
      *(u32x2*)(Vs + nb * (64 * 68) + lr * 68 + lc * 8 + 4) = (u32x2){rv.z, rv.w};
    }
    __syncthreads();
  }
  const float ltot = lsum + __shfl_xor(lsum, 32), inv = 1.f / ltot;
  float ss = 0.f;
#pragma unroll
  for (int i = 0; i < 16; ++i) { o0[i] *= inv; o1[i] *= inv; ss += o0[i] * o0[i] + o1[i] * o1[i]; }
  ss += __shfl_xor(ss, 32);
  const float rstd = rsqrtf(ss * (1.f / 64.f) + EPS);
  const float* g = p.out_norm_g + layer * 1024 + head * 64;
  bf16_t* dst = (bf16_t*)(ws + OFF_U) + (size_t)qrow * 1024 + head * 64;
#pragma unroll
  for (int i4 = 0; i4 < 4; ++i4) {
    const int d = 8 * i4 + 4 * h;
    const f32x4 g0 = *(const f32x4*)(g + d), g1 = *(const f32x4*)(g + 32 + d);
    u32x2 w0, w1;
    w0.x = pk2(o0[4 * i4] * rstd * g0.x, o0[4 * i4 + 1] * rstd * g0.y); w0.y = pk2(o0[4 * i4 + 2] * rstd * g0.z, o0[4 * i4 + 3] * rstd * g0.w);
    w1.x = pk2(o1[4 * i4] * rstd * g1.x, o1[4 * i4 + 1] * rstd * g1.y); w1.y = pk2(o1[4 * i4 + 2] * rstd * g1.z, o1[4 * i4 + 3] * rstd * g1.w);
    *(u32x2*)(dst + d) = w0; *(u32x2*)(dst + 32 + d) = w1;
  }
}

DI float hy_sc(const bf16_t* prow, int t, int n, float w0, float w1, float w2, float bias) {
  const float xm = t > 0 ? bf2f(prow[t - 1]) : 0.f, x0 = bf2f(prow[t]), xp = t + 1 < n ? bf2f(prow[t + 1]) : 0.f;
  return w0 * xm + w1 * x0 + w2 * xp + bias;
}

DI void hyena_lat_item(const Params& p, unsigned char* lds, int layer, int b, int pr, int tid) {
  unsigned char* ws = p.ws;
  float2* buf = (float2*)lds;
  const int ca = 2 * pr;
  const bf16_t* hyp = (const bf16_t*)(ws + OFF_HYP) + (size_t)b * 768 * NKEY;
  const float* cw = p.hy_conv_w + (size_t)layer * 3 * 768; const float* cbias = p.hy_conv_b + (size_t)layer * 768;
  const float* hb = p.hy_bias + (size_t)layer * 512;
  float w[3][2][4];
#pragma unroll
  for (int s = 0; s < 3; ++s)
#pragma unroll
    for (int e = 0; e < 2; ++e) { const int c = s * 256 + ca + e; w[s][e][0] = cw[c]; w[s][e][1] = cw[768 + c]; w[s][e][2] = cw[1536 + c]; w[s][e][3] = cbias[c]; }
  const bf16_t* pv0 = hyp + (size_t)(ca) * NKEY; const bf16_t* pv1 = hyp + (size_t)(ca + 1) * NKEY;
  const bf16_t* p10 = hyp + (size_t)(256 + ca) * NKEY; const bf16_t* p11 = hyp + (size_t)(256 + ca + 1) * NKEY;
  const bf16_t* p20 = hyp + (size_t)(512 + ca) * NKEY; const bf16_t* p21 = hyp + (size_t)(512 + ca + 1) * NKEY;
  float* outa = (float*)(ws + OFF_HYRAW) + ((size_t)b * 256 + ca) * NKEY; float* outb = outa + NKEY;
  const float b0a = hb[ca], b0b = hb[ca + 1], b1a = hb[256 + ca], b1b = hb[256 + ca + 1];
  __syncthreads();
#pragma unroll 2
  for (int t = tid; t < 8192; t += NT) {
    buf[t] = make_float2(hy_sc(pv0, t, 8192, w[0][0][0], w[0][0][1], w[0][0][2], w[0][0][3]), hy_sc(pv1, t, 8192, w[0][1][0], w[0][1][1], w[0][1][2], w[0][1][3]));
    buf[8192 + t] = make_float2(0.f, 0.f);
  }
  __syncthreads();
  fft_fwd(buf, tid);
  spec_mul(buf, (const float4*)(ws + OFF_SPEC) + (size_t)(0 * 128 + pr) * 8193, tid);
  fft_inv(buf, tid);
#pragma unroll 2
  for (int t = tid; t < 8192; t += NT) {
    const float2 y = buf[t];
    const float va = hy_sc(pv0, t, 8192, w[0][0][0], w[0][0][1], w[0][0][2], w[0][0][3]), vb = hy_sc(pv1, t, 8192, w[0][1][0], w[0][1][1], w[0][1][2], w[0][1][3]);
    const float xa = hy_sc(p10, t, 8192, w[1][0][0], w[1][0][1], w[1][0][2], w[1][0][3]), xb = hy_sc(p11, t, 8192, w[1][1][0], w[1][1][1], w[1][1][2], w[1][1][3]);
    const float za = xa * (y.x * (1.f / 16384.f) + va * b0a), zb = xb * (y.y * (1.f / 16384.f) + vb * b0b);
    outa[t] = za; outb[t] = zb;
    buf[t] = make_float2(za, zb);
  }
#pragma unroll 2
  for (int t = tid; t < 8192; t += NT) buf[8192 + t] = make_float2(0.f, 0.f);
  __syncthreads();
  fft_fwd(buf, tid);
  spec_mul(buf, (const float4*)(ws + OFF_SPEC) + (size_t)(1 * 128 + pr) * 8193, tid);
  fft_inv(buf, tid);
#pragma unroll 2
  for (int t = tid; t < 8192; t += NT) {
    const float2 y = buf[t];
    const float xa = hy_sc(p20, t, 8192, w[2][0][0], w[2][0][1], w[2][0][2], w[2][0][3]), xb = hy_sc(p21, t, 8192, w[2][1][0], w[2][1][1], w[2][1][2], w[2][1][3]);
    const float za = outa[t], zb = outb[t];
    outa[t] = xa * (y.x * (1.f / 16384.f) + za * b1a);
    outb[t] = xb * (y.y * (1.f / 16384.f) + zb * b1b);
  }
  __syncthreads();
}

DI void hyena_ctx_item(const Params& p, unsigned char* lds, int layer, int b, int pr, int tid) {
  unsigned char* ws = p.ws;
  float* lf = (float*)lds;
  const int cs = tid >> 8, t = tid & 255, c = 2 * pr + cs;
  float* vv = lf + cs * 256; float* zz = lf + 512 + cs * 256;
  float* hp0 = lf + 1024 + cs * 256; float* hn0 = lf + 1536 + cs * 256; float* hp1 = lf + 2048 + cs * 256; float* hn1 = lf + 2560 + cs * 256;
  const bf16_t* hyp = (const bf16_t*)(ws + OFF_HYP) + (size_t)b * 768 * NKEY + 8192;
  const float* cw = p.hy_conv_w + (size_t)layer * 3 * 768; const float* cbias = p.hy_conv_b + (size_t)layer * 768;
  const float* hb = p.hy_bias + (size_t)layer * 512;
  const float* hc = (const float*)(ws + OFF_HC) + (size_t)t * 1024;
  const float uv = hy_sc(hyp + (size_t)c * NKEY, t, 256, cw[c], cw[768 + c], cw[1536 + c], cbias[c]);
  const float x1 = hy_sc(hyp + (size_t)(256 + c) * NKEY, t, 256, cw[256 + c], cw[768 + 256 + c], cw[1536 + 256 + c], cbias[256 + c]);
  const float x2 = hy_sc(hyp + (size_t)(512 + c) * NKEY, t, 256, cw[512 + c], cw[768 + 512 + c], cw[1536 + 512 + c], cbias[512 + c]);
  __syncthreads();
  vv[t] = uv; hp0[t] = hc[c]; hn0[t] = hc[256 + c]; hp1[t] = hc[512 + c]; hn1[t] = hc[768 + c];
  __syncthreads();
  float y = 0.f;
  for (int s = 0; s < 256; ++s) y += (s <= t ? hp0[t - s] : hn0[s - t]) * vv[s];
  const float z = x1 * (y + hb[c] * uv);
  zz[t] = z;
  __syncthreads();
  float y2 = 0.f;
  for (int s = 0; s < 256; ++s) y2 += (s <= t ? hp1[t - s] : hn1[s - t]) * zz[s];
  ((float*)(ws + OFF_HYRAW))[((size_t)b * 256 + c) * NKEY + 8192 + t] = x2 * (y2 + hb[256 + c] * z);
  __syncthreads();
}

DI void hyena_norm_item(const Params& p, unsigned char* lds, int layer, int b, int tt, int tid) {
  unsigned char* ws = p.ws;
  float* tile = (float*)lds;
  float* ssb = tile + 256 * 65;
  const int lane = tid & 63, wave = tid >> 6;
  const float* src = (const float*)(ws + OFF_HYRAW) + (size_t)b * 256 * NKEY + tt * 64;
  __syncthreads();
#pragma unroll 4
  for (int i = 0; i < 32; ++i) { const int ch = i * 8 + wave; tile[ch * 65 + lane] = src[(size_t)ch * NKEY + lane]; }
  __syncthreads();
  float v[32]; float ss = 0.f;
#pragma unroll
  for (int j = 0; j < 32; ++j) { v[j] = tile[(wave * 32 + j) * 65 + lane]; ss += v[j] * v[j]; }
  ssb[wave * 64 + lane] = ss;
  __syncthreads();
  const float rstd = rsqrtf((ssb[(wave & ~1) * 64 + lane] + ssb[(wave | 1) * 64 + lane]) * (1.f / 64.f) + EPS);
  const int tok = tt * 64 + lane;
  const int row = tok < 8192 ? b * 8192 + tok : 16384 + b * 256 + (tok - 8192);
  const float* g = p.out_norm_g + layer * 1024 + 512 + wave * 32;
  bf16_t* dst = (bf16_t*)(ws + OFF_U) + (size_t)row * 1024 + 512 + wave * 32;
#pragma unroll
  for (int c8 = 0; c8 < 4; ++c8) {
    u32x4 w;
    w.x = pk2(v[c8 * 8] * rstd * g[c8 * 8], v[c8 * 8 + 1] * rstd * g[c8 * 8 + 1]); w.y = pk2(v[c8 * 8 + 2] * rstd * g[c8 * 8 + 2], v[c8 * 8 + 3] * rstd * g[c8 * 8 + 3]);
    w.z = pk2(v[c8 * 8 + 4] * rstd * g[c8 * 8 + 4], v[c8 * 8 + 5] * rstd * g[c8 * 8 + 5]); w.w = pk2(v[c8 * 8 + 6] * rstd * g[c8 * 8 + 6], v[c8 * 8 + 7] * rstd * g[c8 * 8 + 7]);
    *(u32x4*)(dst + c8 * 8) = w;
  }
}

DI void gla_gates(const Params& p, int layer, const float* lr, int c, float& zf, float& zb) {
  const float* gw = p.gla_gate_w + (size_t)layer * 2 * 16 * 128 + c;
  float a = p.gla_gate_b[layer * 256 + c], b = p.gla_gate_b[layer * 256 + 128 + c];
#pragma unroll
  for (int r4 = 0; r4 < 4; ++r4) {
    const f32x4 lf = *(const f32x4*)(lr + r4 * 4), lb = *(const f32x4*)(lr + 16 + r4 * 4);
    a += lf.x * gw[(r4 * 4) * 128] + lf.y * gw[(r4 * 4 + 1) * 128] + lf.z * gw[(r4 * 4 + 2) * 128] + lf.w * gw[(r4 * 4 + 3) * 128];
    b += lb.x * gw[(16 + r4 * 4) * 128] + lb.y * gw[(16 + r4 * 4 + 1) * 128] + lb.z * gw[(16 + r4 * 4 + 2) * 128] + lb.w * gw[(16 + r4 * 4 + 3) * 128];
  }
  zf = log_sigmoid(a) * 0.0625f; zb = log_sigmoid(b) * 0.0625f;
}

DI int gla_row(int b, int sc, int i) { return sc < 128 ? b * 8192 + sc * 64 + i : 16384 + b * 256 + (sc - 128) * 64 + i; }

DI void gla_local_item(const Params& p, unsigned char* lds, int layer, int b, int sc, int h, int tid) {
  unsigned char* ws = p.ws;
  float* lf = (float*)lds;
  float* kt = lf;
  float* vs = lf + 2 * 64 * 33;
  float* lg = vs + 64 * 64;
  const int row0 = gla_row(b, sc, 0);
  const float* gk = (const float*)(ws + OFF_GK) + (size_t)row0 * 128 + h * 32;
  const float* gv = (const float*)(ws + OFF_GV) + (size_t)row0 * 256 + h * 64;
  const float* lr = (const float*)(ws + OFF_LR) + (size_t)row0 * 32;
  __syncthreads();
  for (int e = tid; e < 2048; e += NT) {
    const int i = e >> 5, d = e & 31; const float kk = gk[i * 128 + d]; kt[i * 33 + d] = kk; kt[64 * 33 + i * 33 + d] = kk;
    float zf, zb; gla_gates(p, layer, lr + i * 32, h * 32 + d, zf, zb);
    lg[i * 33 + d] = zf; lg[64 * 33 + i * 33 + d] = zb;
  }
  for (int e = tid; e < 4096; e += NT) { const int i = e >> 6, d = e & 63; vs[e] = gv[i * 256 + d]; }
  __syncthreads();
  if (tid < 64) {
    const int dir = tid >> 5, d = tid & 31;
    float* l = lg + dir * 64 * 33; float* k = kt + dir * 64 * 33;
    float tot = 0.f;
    for (int i = 0; i < 64; ++i) tot += l[i * 33 + d];
    float cum = 0.f;
    if (dir == 0) { for (int i = 0; i < 64; ++i) { cum += l[i * 33 + d]; k[i * 33 + d] *= __expf(tot - cum); } }
    else { for (int i = 63; i >= 0; --i) { cum += l[i * 33 + d]; k[i * 33 + d] *= __expf(tot - cum); } }
    ((float*)(ws + OFF_DEC))[(((size_t)(dir * 2 + b) * 4 + h) * 132 + sc) * 32 + d] = __expf(tot);
  }
  __syncthreads();
  {
    const int dir = tid >> 8, dk = (tid >> 3) & 31, dv0 = (tid & 7) * 8;
    const float* k = kt + dir * 64 * 33 + dk;
    float acc[8];
#pragma unroll
    for (int e = 0; e < 8; ++e) acc[e] = 0.f;
#pragma unroll 4
    for (int j = 0; j < 64; ++j) {
      const float kk = k[j * 33];
      const f32x4 v0 = *(const f32x4*)(vs + j * 64 + dv0), v1 = *(const f32x4*)(vs + j * 64 + dv0 + 4);
      acc[0] += kk * v0.x; acc[1] += kk * v0.y; acc[2] += kk * v0.z; acc[3] += kk * v0.w;
      acc[4] += kk * v1.x; acc[5] += kk * v1.y; acc[6] += kk * v1.z; acc[7] += kk * v1.w;
    }
    float* dst = (float*)(ws + OFF_KV) + ((((size_t)(dir * 2 + b) * 4 + h) * 132 + sc) * 32 + dk) * 64 + dv0;
    *(f32x4*)dst = (f32x4){acc[0], acc[1], acc[2], acc[3]}; *(f32x4*)(dst + 4) = (f32x4){acc[4], acc[5], acc[6], acc[7]};
  }
}

DI void gla_scan(const Params& p, int tid) {
  unsigned char* ws = p.ws;
  for (int blk = blockIdx.x; blk < 64; blk += gridDim.x) {
    const int chain = blk >> 2, e = (blk & 3) * 512 + tid, dk = e >> 6, dir = chain >> 3;
    float* kv = (float*)(ws + OFF_KV) + (size_t)chain * 132 * 2048 + e;
    const float* dec = (const float*)(ws + OFF_DEC) + (size_t)chain * 132 * 32 + dk;
    float state = 0.f;
    for (int s0 = 0; s0 < 132; s0 += 4) {
      float kvv[4], dd[4]; int scs[4];
#pragma unroll
      for (int q = 0; q < 4; ++q) {
        const int s = s0 + q;
        const int sc = dir == 0 ? (s < 4 ? 128 + s : s - 4) : 131 - s;
        scs[q] = sc; kvv[q] = kv[(size_t)sc * 2048]; dd[q] = dec[sc * 32];
      }
#pragma unroll
      for (int q = 0; q < 4; ++q) { kv[(size_t)scs[q] * 2048] = state; state = dd[q] * state + kvv[q]; }
    }
  }
}

DI void gla_out_item(const Params& p, unsigned char* lds, int layer, int b, int sc, int h, int tid) {
  unsigned char* ws = p.ws;
  float* lf = (float*)lds;
  float* qf = lf;
  float* qb = qf + 64 * 33;
  float* kf = qb + 64 * 33;
  float* kb = kf + 64 * 33;
  float* gf = kb + 64 * 33;
  float* gb = gf + 64 * 33;
  float* vs = gb + 64 * 33;
  float* S = vs + 4096;
  float* spf = S + 64 * 65;
  float* spb = spf + 2048;
  const int row0 = gla_row(b, sc, 0);
  const float* gq = (const float*)(ws + OFF_GQ) + (size_t)row0 * 128 + h * 32;
  const float* gk = (const float*)(ws + OFF_GK) + (size_t)row0 * 128 + h * 32;
  const float* gv = (const float*)(ws + OFF_GV) + (size_t)row0 * 256 + h * 64;
  const float* lr = (const float*)(ws + OFF_LR) + (size_t)row0 * 32;
  const float* pf = (const float*)(ws + OFF_KV) + (((size_t)(0 * 2 + b) * 4 + h) * 132 + sc) * 2048;
  const float* pb = (const float*)(ws + OFF_KV) + (((size_t)(1 * 2 + b) * 4 + h) * 132 + sc) * 2048;
  __syncthreads();
  for (int e = tid; e < 2048; e += NT) {
    const int i = e >> 5, d = e & 31; const float q = gq[i * 128 + d], k = gk[i * 128 + d];
    float zf, zb; gla_gates(p, layer, lr + i * 32, h * 32 + d, zf, zb);
    qf[i * 33 + d] = q; qb[i * 33 + d] = q; kf[i * 33 + d] = k; kb[i * 33 + d] = k; gf[i * 33 + d] = zf; gb[i * 33 + d] = zb;
    spf[e] = pf[e]; spb[e] = pb[e];
  }
  for (int e = tid; e < 4096; e += NT) { const int i = e >> 6, d = e & 63; vs[e] = gv[i * 256 + d]; }
  __syncthreads();
  if (tid < 64) {
    const int dir = tid >> 5, d = tid & 31;
    float cum = 0.f;
    if (dir == 0) { for (int i = 0; i < 64; ++i) { cum += gf[i * 33 + d]; qf[i * 33 + d] *= __expf(cum); kf[i * 33 + d] *= __expf(-cum); } }
    else { for (int i = 63; i >= 0; --i) { cum += gb[i * 33 + d]; qb[i * 33 + d] *= __expf(cum); kb[i * 33 + d] *= __expf(-cum); } }
  }
  __syncthreads();
  {
    const int i = tid >> 3;
#pragma unroll 1
    for (int jj = 0; jj < 8; ++jj) {
      const int j = (tid & 7) + 8 * jj;
      float s = 0.f;
      if (j <= i) {
#pragma unroll 8
        for (int d = 0; d < 32; ++d) s += qf[i * 33 + d] * kf[j * 33 + d]; }
      if (j >= i) {
#pragma unroll 8
        for (int d = 0; d < 32; ++d) s += qb[i * 33 + d] * kb[j * 33 + d]; }
      S[i * 65 + j] = s;
    }
  }
  __syncthreads();
  {
    const int i = tid >> 3, dv0 = (tid & 7) * 8;
    float acc[8];
#pragma unroll
    for (int e = 0; e < 8; ++e) acc[e] = 0.f;
#pragma unroll 4
    for (int j = 0; j < 64; ++j) {
      const float s = S[i * 65 + j];
      const f32x4 v0 = *(const f32x4*)(vs + j * 64 + dv0), v1 = *(const f32x4*)(vs + j * 64 + dv0 + 4);
      acc[0] += s * v0.x; acc[1] += s * v0.y; acc[2] += s * v0.z; acc[3] += s * v0.w; acc[4] += s * v1.x; acc[5] += s * v1.y; acc[6] += s * v1.z; acc[7] += s * v1.w;
    }
#pragma unroll 2
    for (int d = 0; d < 32; ++d) {
      const float a = qf[i * 33 + d], c = qb[i * 33 + d];
      const f32x4 f0 = *(const f32x4*)(spf + d * 64 + dv0), f1 = *(const f32x4*)(spf + d * 64 + dv0 + 4);
      const f32x4 b0 = *(const f32x4*)(spb + d * 64 + dv0), b1 = *(const f32x4*)(spb + d * 64 + dv0 + 4);
      acc[0] += a * f0.x + c * b0.x; acc[1] += a * f0.y + c * b0.y; acc[2] += a * f0.z + c * b0.z; acc[3] += a * f0.w + c * b0.w;
      acc[4] += a * f1.x + c * b1.x; acc[5] += a * f1.y + c * b1.y; acc[6] += a * f1.z + c * b1.z; acc[7] += a * f1.w + c * b1.w;
    }
    float ss = 0.f;
#pragma unroll
    for (int e = 0; e < 8; ++e) ss += acc[e] * acc[e];
    ss += __shfl_xor(ss, 1); ss += __shfl_xor(ss, 2); ss += __shfl_xor(ss, 4);
    const float rstd = rsqrtf(ss * (1.f / 64.f) + EPS);
    const int row = row0 + i;
    const float* g = p.out_norm_g + layer * 1024 + 768 + h * 64 + dv0;
    const float* gr = (const float*)(ws + OFF_GR) + (size_t)row * 256 + h * 64 + dv0;
    float o[8];
#pragma unroll
    for (int e = 0; e < 8; ++e) o[e] = acc[e] * rstd * g[e] * siluf(gr[e]);
    u32x4 w; w.x = pk2(o[0], o[1]); w.y = pk2(o[2], o[3]); w.z = pk2(o[4], o[5]); w.w = pk2(o[6], o[7]);
    *(u32x4*)((bf16_t*)(ws + OFF_U) + (size_t)row * 1024 + 768 + h * 64 + dv0) = w;
  }
}

DI void p3_run(const Params& p, unsigned char* lds, int layer, int* cnt, int tid, int* s_item_p) {
  for (;;) {
    __syncthreads();
    if (tid == 0) *s_item_p = atomicAdd(cnt, 1);
    __syncthreads();
    const int it = *s_item_p;
    if (it >= 2096) break;
    if (it < 512) { const int b = it >> 8, r = it & 255; attn_unit(p, lds, layer, b, r >> 5, b * 8192 + (r & 31) * 256, 0, NKEY, tid); }
    else if (it < 768) { const int i = it - 512; hyena_lat_item(p, lds, layer, i >> 7, i & 127, tid); }
    else if (it < 784) { const int i = it - 768, b = i >> 3; attn_unit(p, lds, layer, b, i & 7, 16384 + b * 256, 8192, 256, tid); }
    else if (it < 1040) { const int i = it - 784; hyena_ctx_item(p, lds, layer, i >> 7, i & 127, tid); }
    else { const int i = it - 1040, b = i / 528, r = i % 528; gla_local_item(p, lds, layer, b, r >> 2, r & 3, tid); }
  }
}

__global__ void __launch_bounds__(NT) mk_fwd(Params p_arg) {
  extern __shared__ __attribute__((aligned(16))) unsigned char lds[];
  __shared__ int s_item;
  cg::grid_group grid = cg::this_grid();
  int tid = threadIdx.x;
  typedef const __attribute__((address_space(4))) Params* KP;
#if defined(__HIP_DEVICE_COMPILE__)
  const KP kp = (KP)__builtin_amdgcn_kernarg_segment_ptr();
  unsigned char* ws = kp->ws;
#else
  unsigned char* ws = p_arg.ws;
#endif
#define OPQ() asm volatile("" : "+v"(tid))
#if defined(__HIP_DEVICE_COMPILE__)
#define LOADP() KP kq_ = kp; asm volatile("" : "+s"(kq_)); Params p; p.x = kq_->x; p.c = kq_->c; p.ctx = kq_->ctx; p.c_ctx = kq_->c_ctx; p.ada_w = kq_->ada_w; p.ada_b = kq_->ada_b; p.norm1_g = kq_->norm1_g; p.w_in = kq_->w_in; p.q_norm_g = kq_->q_norm_g; p.k_norm_g = kq_->k_norm_g; p.hy_conv_w = kq_->hy_conv_w; p.hy_conv_b = kq_->hy_conv_b; p.filt_w1 = kq_->filt_w1; p.filt_b1 = kq_->filt_b1; p.filt_w2 = kq_->filt_w2; p.filt_b2 = kq_->filt_b2; p.filt_w3 = kq_->filt_w3; p.filt_freq = kq_->filt_freq; p.hy_bias = kq_->hy_bias; p.gla_gate_w = kq_->gla_gate_w; p.gla_gate_b = kq_->gla_gate_b; p.out_norm_g = kq_->out_norm_g; p.w_out = kq_->w_out; p.norm2_g = kq_->norm2_g; p.ffn_w1 = kq_->ffn_w1; p.ffn_w3 = kq_->ffn_w3; p.ffn_w2 = kq_->ffn_w2; p.final_norm_g = kq_->final_norm_g; p.out = kq_->out; p.ws = kq_->ws;
#else
#define LOADP() Params p = p_arg
#endif
  { LOADP(); if (PH & 1) phase0(p, lds, tid); }
  grid.sync();
  for (int layer = 0; layer < 4; ++layer) {
    OPQ();
    { LOADP(); if (PH & 2) spectra_items(p, layer, lds, tid); }
    OPQ();
    { LOADP(); if (PH & 4) ctx_filters(p, layer, tid); }
    OPQ();
    { LOADP(); if (PH & 8) weight_prep(p, layer, lds, tid); }
    OPQ();
    { LOADP(); if (PH & 16) norm_rows(p, layer, 0, tid); }
    grid.sync();
    OPQ();
    {
      LOADP();
      pg8::Gemm g{(const bf16_t*)(ws + OFF_U), (const bf16_t*)(ws + OFF_WIN), TOK, 2560, 1024}; pg8::StaticOrder S; S.init(TOK, 2560, gridDim.x, blockIdx.x);
      EpiInproj E{ws, p.q_norm_g + layer * 64, p.k_norm_g + layer * 64};
      if (PH & 32) pg8::gemm_phase<EpiInproj, pg8::StaticOrder, true, true>((PG8_LAS unsigned char*)lds, g, S, E, tid);
    }
    grid.sync();
    OPQ();
    { int nrep = REP3; asm volatile("" : "+s"(nrep));
#pragma unroll 1
      for (int rep = 0; rep < nrep; ++rep) { OPQ(); LOADP(); p3_run(p, lds, layer, (int*)(ws + OFF_CNT) + layer + 8 * rep, tid, &s_item); } }
    grid.sync();
    OPQ();
    { LOADP(); if (PH & 128) gla_scan(p, tid); }
    OPQ();
    { LOADP(); if (PH & 256) for (int it = blockIdx.x; it < 264; it += gridDim.x) hyena_norm_item(p, lds, layer, it / 132, it % 132, tid); }
    grid.sync();
    OPQ();
    { LOADP(); if (PH & 512) for (int it = blockIdx.x; it < 1056; it += gridDim.x) { const int b = it / 528, r = it % 528; gla_out_item(p, lds, layer, b, r >> 2, r & 3, tid); } }
    grid.sync();
    OPQ();
    {
      pg8::Gemm g{(const bf16_t*)(ws + OFF_U), (const bf16_t*)(ws + OFF_WOUT), 16384, 1024, 1024}; pg8::StaticOrder S; S.init(16384, 1024, gridDim.x, blockIdx.x);
      EpiResid E{(float*)(ws + OFF_HRES), (const float*)(ws + OFF_MOD) + layer * 3 * 6144, 2048};
      if (PH & 1024) pg8::gemm_phase<EpiResid, pg8::StaticOrder, true, true>((PG8_LAS unsigned char*)lds, g, S, E, tid);
      OPQ();
      if (PH & 4096) if (layer < 3) { LOADP(); gemm_ctx(p, lds, (const bf16_t*)(ws + OFF_U), (const bf16_t*)(ws + OFF_WOUT), 1024, 1024, layer, 2048, 64, 2, tid); }
    }
    grid.sync();
    OPQ();
    { LOADP(); if (PH & 16) norm_rows(p, layer, 1, tid); }
    grid.sync();
    OPQ();
    {
      const int Mr = layer < 3 ? TOK : 16384;
      pg8::Gemm g{(const bf16_t*)(ws + OFF_U), (const bf16_t*)(ws + OFF_W13), Mr, 5632, 1024}; pg8::StaticOrder S; S.init(Mr, 5632, gridDim.x, blockIdx.x);
      EpiSwiglu E{(bf16_t*)(ws + OFF_HMID)};
      if (PH & 2048) pg8::gemm_phase<EpiSwiglu, pg8::StaticOrder, true, true>((PG8_LAS unsigned char*)lds, g, S, E, tid);
    }
    grid.sync();
    OPQ();
    {
      pg8::Gemm g{(const bf16_t*)(ws + OFF_HMID), (const bf16_t*)(ws + OFF_W2), 16384, 1024, 2816}; pg8::StaticOrder S; S.init(16384, 1024, gridDim.x, blockIdx.x);
      EpiResid E{(float*)(ws + OFF_HRES), (const float*)(ws + OFF_MOD) + layer * 3 * 6144, 5120};
      if (PH & 8192) pg8::gemm_phase<EpiResid, pg8::StaticOrder, true, true>((PG8_LAS unsigned char*)lds, g, S, E, tid);
      OPQ();
      if (PH & 4096) if (layer < 3) { LOADP(); gemm_ctx(p, lds, (const bf16_t*)(ws + OFF_HMID), (const bf16_t*)(ws + OFF_W2), 1024, 2816, layer, 5120, 64, 2, tid); }
    }
    grid.sync();
  }
  OPQ();
  {
    LOADP();
    const int lane = tid & 63, gw = blockIdx.x * 8 + (tid >> 6), nw = gridDim.x * 8;
    const float* hres = (const float*)(ws + OFF_HRES);
    for (int row = gw; row < 16384; row += nw) {
      const f32x4* xr = (const f32x4*)(hres + (size_t)row * 1024) + lane;
      f32x4 v[4]; float s = 0.f;
#pragma unroll
      for (int j = 0; j < 4; ++j) { v[j] = xr[64 * j]; s += v[j].x * v[j].x + v[j].y * v[j].y + v[j].z * v[j].z + v[j].w * v[j].w; }
      const float rstd = rsqrtf(wave_sum(s) * (1.f / 1024.f) + EPS);
#pragma unroll
      for (int j = 0; j < 4; ++j) {
        const int col = lane * 4 + 256 * j;
        *(f32x4*)(p.out + (size_t)row * 1024 + col) = v[j] * rstd * *(const f32x4*)(p.final_norm_g + col);
      }
    }
  }
}

extern "C" void kernel_launch(void* const* d_in, const int* in_sizes, int n_in, void* d_out, int out_size, void* d_ws, size_t ws_size, hipStream_t stream) {
  static int grid_blocks = 0;
  if (!grid_blocks) {
    int dev = 0, cus = 0, per_cu = 0;
    hipGetDevice(&dev);
    hipDeviceGetAttribute(&cus, hipDeviceAttributeMultiprocessorCount, dev);
    hipFuncSetAttribute((const void*)mk_fwd, hipFuncAttributeMaxDynamicSharedMemorySize, LDS_BYTES);
    hipOccupancyMaxActiveBlocksPerMultiprocessor(&per_cu, (const void*)mk_fwd, NT, LDS_BYTES);
    if (per_cu < 1) per_cu = 1;
    grid_blocks = cus * per_cu;
    if (ws_size < WS_NEED || n_in != 28) { fprintf(stderr, "kernel_launch: ws_size %zu < %llu or n_in %d != 28\n", ws_size, (unsigned long long)WS_NEED, n_in); grid_blocks = -1; }
  }
  if (grid_blocks < 0) return;
  Params p{};
  const float** pp = (const float**)&p;
  for (int i = 0; i < 28; ++i) pp[i] = (const float*)d_in[i];
  p.out = (float*)d_out; p.ws = (unsigned char*)d_ws;
  void* args[] = {&p};
  hipError_t e = hipLaunchCooperativeKernel((const void*)mk_fwd, dim3(grid_blocks), dim3(NT), args, LDS_BYTES, stream);
  if (e != hipSuccess) fprintf(stderr, "cooperative launch failed: %s (grid %d)\n", hipGetErrorString(e), grid_blocks);
}
```

```cpp
#include <hip/hip_runtime.h>
#include <hip/hip_cooperative_groups.h>
#include <cstdio>
namespace cg = cooperative_groups;

typedef unsigned short bf16_t;
typedef short bf16x8 __attribute__((ext_vector_type(8)));
typedef short s16x4 __attribute__((ext_vector_type(4)));
typedef float f32x4 __attribute__((ext_vector_type(4)));
typedef float f32x16 __attribute__((ext_vector_type(16)));
typedef unsigned u32x4 __attribute__((ext_vector_type(4)));
typedef unsigned u32x2 __attribute__((ext_vector_type(2)));

#define NT 512
#ifndef PH
#define PH 0xffff
#endif
#ifndef REP3
#define REP3 1
#endif
#ifndef REPG
#define REPG 1
#endif
#define LDS_BYTES 143360
#define TOK 16896
#define DM 1024
#define NKEY 8448
#define FFH 2816
#define EPS 1e-6f

#define OFF_CNT 0ULL
#define OFF_MOD 4096ULL
#define OFF_ROPE 299008ULL
#define OFF_H2L 2396160ULL
#define OFF_H2C 10784768ULL
#define OFF_HC 11046912ULL
#define OFF_HRES 12095488ULL
#define OFF_U 81301504ULL
#define OFF_Q 115904512ULL
#define OFF_K 133206016ULL
#define OFF_VT 137531392ULL
#define OFF_WIN 141856768ULL
#define OFF_WOUT 147099648ULL
#define OFF_W13 149196800ULL
#define OFF_W2 160731136ULL
#define OFF_SPEC 166498304ULL
#define OFF_HYP 200056832ULL
#define OFF_GQ 226009088ULL
#define OFF_GK 234659840ULL
#define OFF_GV 243310592ULL
#define OFF_GR 260612096ULL
#define OFF_LR 277913600ULL
#define OFF_LGB 286564352ULL
#define OFF_HYRAW 295215104ULL
#define OFF_KV 312516608ULL
#define OFF_DEC 329818112ULL
#define OFF_HMID 200056832ULL
#define OFF_PART 330088448ULL
#define OFF_BAR 353157120ULL
#define OFF_LGF 353173504ULL
#define WS_NEED 361824256ULL

struct Params {
  const float *x, *c, *ctx, *c_ctx, *ada_w, *ada_b, *norm1_g, *w_in, *q_norm_g, *k_norm_g, *hy_conv_w, *hy_conv_b,
      *filt_w1, *filt_b1, *filt_w2, *filt_b2, *filt_w3, *filt_freq, *hy_bias, *gla_gate_w, *gla_gate_b, *out_norm_g,
      *w_out, *norm2_g, *ffn_w1, *ffn_w3, *ffn_w2, *final_norm_g;
  float* out;
  unsigned char* ws;
};

#define DI __device__ __forceinline__
typedef __bf16 bf2_t __attribute__((ext_vector_type(2)));
typedef float f2_t __attribute__((ext_vector_type(2)));
DI unsigned pk2(float a, float b) { const f2_t v = {a, b}; return __builtin_bit_cast(unsigned, __builtin_convertvector(v, bf2_t)); }
DI bf16_t f2bf(float x) { return (bf16_t)(pk2(x, 0.f) & 0xffffu); }
DI float bf2f(bf16_t v) { return __uint_as_float(((unsigned)v) << 16); }
DI float wave_sum(float v) {
#pragma unroll
  for (int o = 1; o < 64; o <<= 1) v += __shfl_xor(v, o);
  return v;
}
DI float siluf(float x) { return x / (1.f + __expf(-x)); }
DI int bidx() { int b = blockIdx.x; asm volatile("" : "+s"(b)); return b; }
DI int gdim() { int g = gridDim.x; asm volatile("" : "+s"(g)); return g; }
DI int row_mod(int row) { return row < 8192 ? 0 : (row < 16384 ? 1 : 2); }

#define XB_TMO      128
#define XB_XCNT(j)  (256  + 64 * (j))
#define XB_XSUB(j)  (1280 + 64 * (j))
#define XB_XGEN(j)  (2304 + 64 * (j))
#define XB_TOP      3328
#define XB_TOPGEN   3392
#define XCD_BAR_WORDS 3456
#define XB_SPIN_CAP (1u << 18)
#define XLAS __attribute__((address_space(3)))

__device__ __forceinline__ unsigned xb_ld(unsigned* p)              { return __hip_atomic_load(p, __ATOMIC_RELAXED, __HIP_MEMORY_SCOPE_AGENT); }
__device__ __forceinline__ unsigned xb_add(unsigned* p, unsigned v) { return __hip_atomic_fetch_add(p, v, __ATOMIC_RELAXED, __HIP_MEMORY_SCOPE_AGENT); }
__device__ __forceinline__ unsigned xb_xcc_id() { return (unsigned)__builtin_amdgcn_s_getreg((3 << 11) | 20) & 0xFu; }
#define XB_SPIN(cond, bar) do { unsigned _sp = 0; while (cond) { __builtin_amdgcn_s_sleep(1); \
    if ((++_sp & 255u) == 0u) { if (xb_ld(&(bar)[XB_TMO])) break; if (_sp > XB_SPIN_CAP) { atomicAdd(&(bar)[XB_TMO], 1u); break; } } } } while (0)

struct XcdBarrier {
    unsigned* bar; unsigned x;
    volatile XLAS unsigned* st;
};

__device__ __forceinline__ XcdBarrier xcd_barrier_post(unsigned* bar, volatile XLAS unsigned* st) {
    XcdBarrier b; b.bar = bar; b.x = xb_xcc_id(); b.st = st;
    if (threadIdx.x == 0) (void)xb_add(&bar[XB_XCNT(b.x)], 1u);
    return b;
}
__device__ __forceinline__ void xcd_barrier_complete(unsigned* bar, unsigned x, unsigned& nloc, unsigned& nx) {
    const unsigned G = gridDim.x;
    unsigned sum, cnt, mine, sp = 0u;
    for (;;) {
        sum = 0u; cnt = 0u; mine = 0u;
#pragma unroll
        for (unsigned j = 0; j < 16; ++j) { const unsigned c = xb_ld(&bar[XB_XCNT(j)]); sum += c; cnt += (c > 0u) ? 1u : 0u; mine = (j == x) ? c : mine; }
        if (sum == G) break;
        __builtin_amdgcn_s_sleep(1);
        if ((++sp & 255u) == 0u) { if (xb_ld(&bar[XB_TMO])) break; if (sp > XB_SPIN_CAP) { atomicAdd(&bar[XB_TMO], 1u); break; } }
    }
    nloc = mine > 0u ? mine : 1u; nx = cnt > 0u ? cnt : 1u;
}

__device__ __forceinline__ void xcd_barrier(const XcdBarrier& b) {
    asm volatile("s_waitcnt vmcnt(0)" ::: "memory");
    __syncthreads();
    if (threadIdx.x == 0) {
        unsigned* bar = b.bar;
        __builtin_amdgcn_s_waitcnt(0);
        unsigned nloc = b.st[0], nx = b.st[1];
        if (nloc == 0u) { xcd_barrier_complete(bar, b.x, nloc, nx); b.st[0] = nloc; b.st[1] = nx; }
        const unsigned old = xb_add(&bar[XB_XSUB(b.x)], 1u);
        const unsigned gen = old / nloc;
        if (old + 1u == (gen + 1u) * nloc) {
            __builtin_amdgcn_fence(__ATOMIC_RELEASE, "agent");
            asm volatile("s_waitcnt vmcnt(0)" ::: "memory");
            const unsigned og = xb_add(&bar[XB_TOP], 1u);
            const unsigned tg = og / nx;
            if (og + 1u == (tg + 1u) * nx) xb_add(&bar[XB_TOPGEN], 1u);
            else XB_SPIN(xb_ld(&bar[XB_TOPGEN]) == tg, bar);
            __builtin_amdgcn_fence(__ATOMIC_ACQUIRE, "agent");
            xb_add(&bar[XB_XGEN(b.x)], 1u);
            asm volatile("s_waitcnt vmcnt(0)" ::: "memory");
        } else {
            XB_SPIN(xb_ld(&bar[XB_XGEN(b.x)]) == gen, bar);
            __builtin_amdgcn_fence(__ATOMIC_ACQUIRE, "agent");
            asm volatile("s_waitcnt vmcnt(0)" ::: "memory");
        }
    }
    __syncthreads();
}


DI void fft_fwd(float2* buf, int tid) {
#pragma unroll 1
  for (int m = 4096; m >= 1; m >>= 2) {
    const float inv4m = 0.25f / (float)m;
#pragma unroll 2
    for (int i = tid; i < 4096; i += NT) {
      const int j = i & (m - 1), i0 = ((i - j) << 2) + j;
      const float2 x0 = buf[i0], x1 = buf[i0 + m], x2 = buf[i0 + 2 * m], x3 = buf[i0 + 3 * m];
      const float f = (float)j * inv4m;
      const float c1 = __builtin_amdgcn_cosf(f), s1 = -__builtin_amdgcn_sinf(f);
      const float c2 = c1 * c1 - s1 * s1, s2 = 2.f * c1 * s1;
      const float a0r = x0.x + x2.x, a0i = x0.y + x2.y, d0r = x0.x - x2.x, d0i = x0.y - x2.y;
      const float a1r = x1.x + x3.x, a1i = x1.y + x3.y, d1r = x1.x - x3.x, d1i = x1.y - x3.y;
      const float a2r = d0r * c1 - d0i * s1, a2i = d0r * s1 + d0i * c1;
      const float e1r = d1i, e1i = -d1r;
      const float a3r = e1r * c1 - e1i * s1, a3i = e1r * s1 + e1i * c1;
      const float b0r = a0r - a1r, b0i = a0i - a1i, b1r = a2r - a3r, b1i = a2i - a3i;
      buf[i0] = make_float2(a0r + a1r, a0i + a1i);
      buf[i0 + m] = make_float2(b0r * c2 - b0i * s2, b0r * s2 + b0i * c2);
      buf[i0 + 2 * m] = make_float2(a2r + a3r, a2i + a3i);
      buf[i0 + 3 * m] = make_float2(b1r * c2 - b1i * s2, b1r * s2 + b1i * c2);
    }
    __syncthreads();
  }
}
DI void fft_inv(float2* buf, int tid) {
#pragma unroll 1
  for (int m = 1; m < 16384; m <<= 2) {
    const float inv4m = 0.25f / (float)m;
#pragma unroll 2
    for (int i = tid; i < 4096; i += NT) {
      const int j = i & (m - 1), i0 = ((i - j) << 2) + j;
      const float2 x0 = buf[i0], x1 = buf[i0 + m], x2 = buf[i0 + 2 * m], x3 = buf[i0 + 3 * m];
      const float f = (float)j * inv4m;
      const float c1 = __builtin_amdgcn_cosf(f), s1 = __builtin_amdgcn_sinf(f);
      const float c2 = c1 * c1 - s1 * s1, s2 = 2.f * c1 * s1;
      const float tr = x1.x * c2 - x1.y * s2, ti = x1.x * s2 + x1.y * c2;
      const float ur = x3.x * c2 - x3.y * s2, ui = x3.x * s2 + x3.y * c2;
      const float a0r = x0.x + tr, a0i = x0.y + ti, a1r = x0.x - tr, a1i = x0.y - ti;
      const float a2r = x2.x + ur, a2i = x2.y + ui, a3r = x2.x - ur, a3i = x2.y - ui;
      const float vr = a2r * c1 - a2i * s1, vi = a2r * s1 + a2i * c1;
      const float qr = a3r * c1 - a3i * s1, qi = a3r * s1 + a3i * c1;
      const float zr = -qi, zi = qr;
      buf[i0] = make_float2(a0r + vr, a0i + vi);
      buf[i0 + 2 * m] = make_float2(a0r - vr, a0i - vi);
      buf[i0 + m] = make_float2(a1r + zr, a1i + zi);
      buf[i0 + 3 * m] = make_float2(a1r - zr, a1i - zi);
    }
    __syncthreads();
  }
}
DI int brev14(int k) { return (int)(__brev((unsigned)k) >> 18); }

DI void spec_pair(float2* buf, const float4 h, int rk, int rnk) {
  const float2 zk = buf[rk], zn = buf[rnk];
  const float ar = 0.5f * (zk.x + zn.x), ai = 0.5f * (zk.y - zn.y);
  const float tr = zk.x - zn.x, ti = zk.y + zn.y;
  const float br = 0.5f * ti, bi = -0.5f * tr;
  const float pr = ar * h.x - ai * h.y, pi = ar * h.y + ai * h.x;
  const float qr = br * h.z - bi * h.w, qi = br * h.w + bi * h.z;
  buf[rk] = make_float2(pr - qi, pi + qr);
  if (rnk != rk) buf[rnk] = make_float2(pr + qi, -pi + qr);
}
struct SpecRegs { float4 h[16]; float4 hl; };
DI void spec_load(SpecRegs& r, const float4* spec, int tid) {
#pragma unroll
  for (int i = 0; i < 16; ++i) r.h[i] = spec[tid + NT * i];
  r.hl = spec[8192];
}
DI void spec_mul(float2* buf, const SpecRegs& r, int tid) {
#pragma unroll
  for (int i = 0; i < 16; ++i) {
    const int idx = tid + NT * i, rk = 2 * idx, k = brev14(rk), rnk = brev14((16384 - k) & 16383);
    spec_pair(buf, r.h[i], rk, rnk);
  }
  if (tid == 0) spec_pair(buf, r.hl, 1, 1);
  __syncthreads();
}

DI void phase0(const Params& p, unsigned char* lds, int tid) {
  unsigned char* ws = p.ws;
  const int G = gdim(), bid = bidx();
  if (bid == 0 && tid < 64) ((int*)(ws + OFF_CNT))[tid] = 0;
  if (bid == 0) for (int i = tid; i < XCD_BAR_WORDS; i += NT) ((unsigned*)(ws + OFF_BAR))[i] = 0u;
  {
    float4* h = (float4*)(ws + OFF_HRES);
    const float4* x = (const float4*)p.x; const float4* cx = (const float4*)p.ctx;
    const int nlat = 16384 * 256, nall = TOK * 256;
    for (int i = bid * NT + tid; i < nall; i += G * NT) h[i] = i < nlat ? x[i] : cx[i - nlat];
  }
  {
    float2* rt = (float2*)(ws + OFF_ROPE);
    for (int i = bid * NT + tid; i < 8192 * 32; i += G * NT) {
      const int pos = i >> 5, f = i & 31;
      const float invf = powf(10000.f, -(float)(f & 15) / 16.f);
      const float ang = (f < 16 ? (float)(pos >> 6) : (float)(pos & 63)) * invf;
      rt[i] = make_float2(cosf(ang), sinf(ang));
    }
  }
  float* lf = (float*)lds;
  for (int it = bid; it < 4 * 96; it += G) {
    const int l = it / 96, c0 = (it % 96) * 64, kg = tid >> 6, col = tid & 63;
    const float* w = p.ada_w + (size_t)l * 1024 * 6144 + c0 + col;
    float a0 = 0.f, a1 = 0.f, a2 = 0.f;
    float* sl = lf + 2048;
    for (int k = tid; k < 1024; k += NT) { sl[k] = siluf(p.c[k]); sl[1024 + k] = siluf(p.c[1024 + k]); sl[2048 + k] = siluf(p.c_ctx[k]); }
    __syncthreads();
#pragma unroll 8
    for (int k = kg * 128; k < kg * 128 + 128; ++k) {
      const float wv = w[(size_t)k * 6144];
      a0 += sl[k] * wv; a1 += sl[1024 + k] * wv; a2 += sl[2048 + k] * wv;
    }
    lf[(kg * 3 + 0) * 64 + col] = a0; lf[(kg * 3 + 1) * 64 + col] = a1; lf[(kg * 3 + 2) * 64 + col] = a2;
    __syncthreads();
    if (tid < 192) {
      const int v = tid >> 6;
      float s = p.ada_b[l * 6144 + c0 + col];
      for (int g = 0; g < 8; ++g) s += lf[(g * 3 + v) * 64 + col];
      ((float*)(ws + OFF_MOD))[(l * 3 + v) * 6144 + c0 + col] = s;
    }
    __syncthreads();
  }
  for (int it = bid; it < 4 * (1024 + 32); it += G) {
    const int l = it / 1056, r = it % 1056, isctx = r >= 1024, n = isctx ? 256 : 8192, tile = isctx ? r - 1024 : r;
    const int ps = tid >> 6, j = tid & 63, pos = tile * 8 + ps;
    float* z = lf; float* h1 = lf + 8 * 33;
    if (j < 33) {
      float val;
      if (j == 0) val = (float)pos / (float)(n - 1);
      else {
        const int kb = (j - 1) & 15;
        const float band = 1e-4f + (float)kb * ((15.f - 1e-4f) / 15.f);
        const float omega = (float)(6.283185307179586 / (double)n) * (float)pos;
        const float ph = omega * band;
        val = (j <= 16) ? cosf(ph) : -sinf(ph);
      }
      z[ps * 33 + j] = val;
    }
    __syncthreads();
    const float fr = p.filt_freq[l * 64 + j];
    float a = p.filt_b1[l * 64 + j];
    for (int e = 0; e < 33; ++e) a += z[ps * 33 + e] * p.filt_w1[(l * 33 + e) * 64 + j];
    h1[ps * 64 + j] = sinf(fr * a);
    __syncthreads();
    float a2 = p.filt_b2[l * 64 + j];
    for (int i = 0; i < 64; ++i) a2 += h1[ps * 64 + i] * p.filt_w2[(l * 64 + i) * 64 + j];
    const float h2 = sinf(fr * a2);
    if (isctx) ((float*)(ws + OFF_H2C))[((size_t)l * 256 + pos) * 64 + j] = h2;
    else ((bf16_t*)(ws + OFF_H2L))[((size_t)l * 8192 + pos) * 64 + j] = f2bf(h2);
    __syncthreads();
  }
}

DI float hy_delta(int c) {
  const float mn = -3.0701134573253944f, mx = -15.350567286626972f;
  return fabsf(mn + (float)c * ((mx - mn) / 255.f));
}

DI void norm_row_load(unsigned char* ws, int row, int nsplit, int glayer, int goff, int lane, f32x4 (&v)[4]) {
  const f32x4* xr = (const f32x4*)((const float*)(ws + OFF_HRES) + (size_t)row * 1024) + lane;
#pragma unroll
  for (int j = 0; j < 4; ++j) v[j] = xr[64 * j];
  if (row >= 16384 && nsplit > 0) {
    const float* pr = (const float*)(ws + OFF_PART) + (size_t)(row - 16384) * 1024 + lane * 4;
    const float* gate = (const float*)(ws + OFF_MOD) + (glayer * 3 + 2) * 6144 + goff + lane * 4;
#pragma unroll
    for (int j = 0; j < 4; ++j) {
      f32x4 a = (f32x4){0.f, 0.f, 0.f, 0.f};
      for (int sp = 0; sp < nsplit; ++sp) a += *(const f32x4*)(pr + (size_t)sp * 512 * 1024 + 256 * j);
      v[j] += *(const f32x4*)(gate + 256 * j) * a;
      *(f32x4*)((float*)(ws + OFF_HRES) + (size_t)row * 1024 + lane * 4 + 256 * j) = v[j];
    }
  }
}
DI void norm_row_store(unsigned char* ws, int row, const float* g, const float* mod, int lane, const f32x4 (&v)[4]) {
  float s = 0.f;
#pragma unroll
  for (int j = 0; j < 4; ++j) s += v[j].x * v[j].x + v[j].y * v[j].y + v[j].z * v[j].z + v[j].w * v[j].w;
  const float rstd = rsqrtf(wave_sum(s) * (1.f / 1024.f) + EPS);
  bf16_t* u = (bf16_t*)(ws + OFF_U);
#pragma unroll
  for (int j = 0; j < 4; ++j) {
    const int col = lane * 4 + 256 * j;
    const f32x4 gg = *(const f32x4*)(g + col), sh = *(const f32x4*)(mod + col), sc = *(const f32x4*)(mod + 1024 + col);
    const f32x4 o = (v[j] * rstd * gg) * (sc + 1.f) + sh;
    u32x2 w; w.x = pk2(o.x, o.y); w.y = pk2(o.z, o.w);
    *(u32x2*)(u + (size_t)row * 1024 + col) = w;
  }
}
DI void norm_rows(const Params& p, int layer, int which  , int tid) {
  unsigned char* ws = p.ws;
  const int nsplit = which ? (layer < 3 ? 4 : 0) : (layer > 0 ? 11 : 0), glayer = which ? layer : layer - 1, goff = which ? 2048 : 5120;
  const int lane = tid & 63, gw = bidx() * 8 + (tid >> 6), nw = gdim() * 8;
  const float* g = (which ? p.norm2_g : p.norm1_g) + layer * 1024;
  const float* modl = (const float*)(ws + OFF_MOD) + layer * 3 * 6144 + which * 3072;
  for (int row = gw; row < TOK; row += 2 * nw) {
    const int row1 = row + nw; const bool has1 = row1 < TOK;
    f32x4 va[4], vb[4];
    norm_row_load(ws, row, nsplit, glayer, goff, lane, va);
    if (has1) norm_row_load(ws, row1, nsplit, glayer, goff, lane, vb);
    norm_row_store(ws, row, g, modl + row_mod(row) * 6144, lane, va);
    if (has1) norm_row_store(ws, row1, g, modl + row_mod(row1) * 6144, lane, vb);
  }
}

DI void wt_item(const float* W, const float* W2, int K, int N, bf16_t* WT, int mode, int kt, int nt, float* tile, int lane) {
  const int k0 = kt * 32, r0 = nt * 64;
  {
    const int r = r0 + lane;
    const float* src = W; int col = r;
    if (mode == 1) { col = (r >> 5) * 16 + (r & 15); if ((r >> 4) & 1) src = W2; }
    else if (mode == 3) {
      if (r < 2304) col = (r & ~255) + 64 * ((r >> 5) & 3) + 32 * ((r >> 4) & 1) + 16 * ((r >> 7) & 1) + (r & 15);
      else if (r >= 2336) col = -1;
    }
    const float* sp = src + (size_t)k0 * N + (col >= 0 ? col : 0);
    float v[32];
#pragma unroll
    for (int i = 0; i < 32; ++i) v[i] = sp[(size_t)i * N];
#pragma unroll
    for (int i = 0; i < 32; ++i) tile[i * 65 + lane] = col >= 0 ? v[i] : 0.f;
  }
#pragma unroll
  for (int i = 0; i < 4; ++i) {
    const int c = lane + 64 * i, n = c >> 2, kc = c & 3;
    const float* sp = tile + (kc * 8) * 65 + n;
    u32x4 o; o.x = pk2(sp[0], sp[65]); o.y = pk2(sp[2 * 65], sp[3 * 65]); o.z = pk2(sp[4 * 65], sp[5 * 65]); o.w = pk2(sp[6 * 65], sp[7 * 65]);
    *(u32x4*)(WT + (size_t)(r0 + n) * K + k0 + kc * 8) = o;
  }
}

DI void weight_prep(const Params& p, int layer, unsigned char* lds, int tid) {
  unsigned char* ws = p.ws;
  const int lane = tid & 63, wave = tid >> 6;
  float* tile = (float*)lds + wave * (32 * 65);
  const int I0 = 32 * 40, I1 = 32 * 16, I2 = 32 * 88, I3 = 88 * 16;
  for (int it = bidx() * 8 + wave; it < I0 + I1 + I2 + I3; it += gdim() * 8) {
    int r = it;
    if (r < I0) { wt_item(p.w_in + (size_t)layer * 1024 * 2336, nullptr, 1024, 2336, (bf16_t*)(ws + OFF_WIN), 3, r / 40, r % 40, tile, lane); continue; } r -= I0;
    if (r < I1) { wt_item(p.w_out + (size_t)layer * 1024 * 1024, nullptr, 1024, 1024, (bf16_t*)(ws + OFF_WOUT), 0, r / 16, r % 16, tile, lane); continue; } r -= I1;
    if (r < I2) { wt_item(p.ffn_w1 + (size_t)layer * 1024 * 2816, p.ffn_w3 + (size_t)layer * 1024 * 2816, 1024, 2816, (bf16_t*)(ws + OFF_W13), 1, r / 88, r % 88, tile, lane); continue; } r -= I2;
    wt_item(p.ffn_w2 + (size_t)layer * 2816 * 1024, nullptr, 2816, 1024, (bf16_t*)(ws + OFF_W2), 0, r / 16, r % 16, tile, lane);
  }
  __syncthreads();
}

DI void ctx_filters(const Params& p, int layer, int tid) {
  unsigned char* ws = p.ws;
  const float* h2c = (const float*)(ws + OFF_H2C) + (size_t)layer * 256 * 64;
  float* hc = (float*)(ws + OFF_HC);
  for (int t = bidx(); t < 256; t += gdim()) {
    const float tn = (float)t / 255.f;
#pragma unroll
    for (int cc = 0; cc < 2; ++cc) {
      const int col = tid + cc * 512;
      float a = 0.f;
      for (int j = 0; j < 64; ++j) a += h2c[t * 64 + j] * p.filt_w3[((size_t)layer * 64 + j) * 1024 + col];
      hc[t * 1024 + col] = a * __expf(-tn * hy_delta(col & 255));
    }
  }
}

DI void spectra_items(const Params& p, int layer, unsigned char* lds, int tid) {
  unsigned char* ws = p.ws;
  float2* buf = (float2*)lds;
  float* w3s = (float*)(lds + 131072);
  const bf16_t* h2l = (const bf16_t*)(ws + OFF_H2L) + (size_t)layer * 8192 * 64;
  for (int it = bidx(); it < 256; it += gdim()) {
    const int o = it >> 7, pr = it & 127, ca = 2 * pr;
    if (tid < 256) {
      const int j = tid >> 2, q = tid & 3, sign = q >> 1, ch = ca + (q & 1);
      w3s[tid] = p.filt_w3[((size_t)layer * 64 + j) * 1024 + o * 512 + sign * 256 + ch];
    }
    __syncthreads();
    const float da = hy_delta(ca), db = hy_delta(ca + 1);
#pragma unroll 1
    for (int t = tid; t < 8192; t += NT) {
      const u32x4* hr = (const u32x4*)(h2l + (size_t)t * 64);
      float a0 = 0.f, a1 = 0.f, a2 = 0.f, a3 = 0.f;
#pragma unroll 4
      for (int jj = 0; jj < 8; ++jj) {
        const u32x4 hq = hr[jj];
#pragma unroll
        for (int e = 0; e < 4; ++e) {
          const float lo = __uint_as_float(hq[e] << 16), hi = __uint_as_float(hq[e] & 0xffff0000u);
          const f32x4 wl = *(const f32x4*)(w3s + (jj * 8 + e * 2) * 4), wh = *(const f32x4*)(w3s + (jj * 8 + e * 2 + 1) * 4);
          a0 += lo * wl.x + hi * wh.x; a1 += lo * wl.y + hi * wh.y; a2 += lo * wl.z + hi * wh.z; a3 += lo * wl.w + hi * wh.w;
        }
      }
      const float tn = (float)t / 8191.f, wa = __expf(-tn * da), wb = __expf(-tn * db);
      buf[t] = make_float2(a0 * wa, a1 * wb);
      if (t == 0) buf[8192] = make_float2(0.f, 0.f);
      else buf[16384 - t] = make_float2(a2 * wa, a3 * wb);
    }
    __syncthreads();
    fft_fwd(buf, tid);
    float4* spec = (float4*)(ws + OFF_SPEC) + (size_t)it * 8193;
#pragma unroll 2
    for (int idx = tid; idx <= 8192; idx += NT) {
      const int rk = idx < 8192 ? 2 * idx : 1, k = brev14(rk), rnk = brev14((16384 - k) & 16383);
      const float2 zk = buf[rk], zn = buf[rnk];
      const float tr = zk.x - zn.x, ti = zk.y + zn.y;
      __builtin_nontemporal_store((f32x4){0.5f * (zk.x + zn.x), 0.5f * (zk.y - zn.y), 0.5f * ti, -0.5f * tr}, (f32x4*)(spec + idx));
    }
    __syncthreads();
  }
}

#define MFMA16(a, b, c) __builtin_amdgcn_mfma_f32_16x16x32_bf16((a), (b), (c), 0, 0, 0)
#define MFMA32(a, b, c) __builtin_amdgcn_mfma_f32_32x32x16_bf16((a), (b), (c), 0, 0, 0)
#define MFMA4F(a, b, c) __builtin_amdgcn_mfma_f32_16x16x4f32((a), (b), (c), 0, 0, 0)
#define LSA 72

DI float log_sigmoid(float z) { return fminf(z, 0.f) - log1pf(__expf(-fabsf(z))); }

DI void gemm_ctx(const Params& p, unsigned char* lds, const bf16_t* A, const bf16_t* Bt, int K, int tid) {
  unsigned char* ws = p.ws;
  const int lane = tid & 63, wave = tid >> 6, wm = wave >> 1, wn = wave & 1, fr = lane & 15, fq = lane >> 4;
  const int S = K / 256, njobs = 16 * S;
  bf16_t* As = (bf16_t*)lds;
  bf16_t* Bs = (bf16_t*)(lds + 73728);
  for (int job = bidx(); job < njobs; job += gdim()) {
    const int tile = job % 16, ks = job / 16, tm = 64 + (tile >> 3), tn = tile & 7;
    const bf16_t* Ag = A + (size_t)(tm * 256) * K + ks * 256;
    const bf16_t* Bg = Bt + (size_t)(tn * 128) * K + ks * 256;
    f32x4 acc[4][4];
#pragma unroll
    for (int m = 0; m < 4; ++m)
#pragma unroll
      for (int n = 0; n < 4; ++n) acc[m][n] = (f32x4){0.f, 0.f, 0.f, 0.f};
    u32x4 ra[4], rb[2];
#pragma unroll
    for (int i = 0; i < 4; ++i) { const int c = tid + NT * i; ra[i] = *(const u32x4*)(Ag + (size_t)(c >> 3) * K + (c & 7) * 8); }
#pragma unroll
    for (int i = 0; i < 2; ++i) { const int c = tid + NT * i; rb[i] = *(const u32x4*)(Bg + (size_t)(c >> 3) * K + (c & 7) * 8); }
#pragma unroll
    for (int i = 0; i < 4; ++i) { const int c = tid + NT * i; *(u32x4*)(As + (c >> 3) * LSA + (c & 7) * 8) = ra[i]; }
#pragma unroll
    for (int i = 0; i < 2; ++i) { const int c = tid + NT * i; *(u32x4*)(Bs + (c >> 3) * LSA + (c & 7) * 8) = rb[i]; }
    __syncthreads();
    for (int kt = 0; kt < 4; ++kt) {
      const int cur = kt & 1;
      if (kt + 1 < 4) {
        const int k0 = (kt + 1) * 64;
#pragma unroll
        for (int i = 0; i < 4; ++i) { const int c = tid + NT * i; ra[i] = *(const u32x4*)(Ag + (size_t)(c >> 3) * K + k0 + (c & 7) * 8); }
#pragma unroll
        for (int i = 0; i < 2; ++i) { const int c = tid + NT * i; rb[i] = *(const u32x4*)(Bg + (size_t)(c >> 3) * K + k0 + (c & 7) * 8); }
      }
      const bf16_t* as = As + cur * (256 * LSA) + (wm * 64 + fr) * LSA + fq * 8;
      const bf16_t* bs = Bs + cur * (128 * LSA) + (wn * 64 + fr) * LSA + fq * 8;
#pragma unroll
      for (int ks2 = 0; ks2 < 2; ++ks2) {
        bf16x8 af[4], bfr[4];
#pragma unroll
        for (int m = 0; m < 4; ++m) af[m] = *(const bf16x8*)(as + m * 16 * LSA + ks2 * 32);
#pragma unroll
        for (int n = 0; n < 4; ++n) bfr[n] = *(const bf16x8*)(bs + n * 16 * LSA + ks2 * 32);
#pragma unroll
        for (int m = 0; m < 4; ++m)
#pragma unroll
          for (int n = 0; n < 4; ++n) acc[m][n] = MFMA16(bfr[n], af[m], acc[m][n]);
      }
      if (kt + 1 < 4) {
        const int nb = cur ^ 1;
#pragma unroll
        for (int i = 0; i < 4; ++i) { const int c = tid + NT * i; *(u32x4*)(As + nb * (256 * LSA) + (c >> 3) * LSA + (c & 7) * 8) = ra[i]; }
#pragma unroll
        for (int i = 0; i < 2; ++i) { const int c = tid + NT * i; *(u32x4*)(Bs + nb * (128 * LSA) + (c >> 3) * LSA + (c & 7) * 8) = rb[i]; }
      }
      __syncthreads();
    }
    float* part = (float*)(ws + OFF_PART) + (size_t)ks * 512 * 1024;
    const int prow0 = (tm - 64) * 256 + wm * 64, col0 = tn * 128 + wn * 64;
#pragma unroll
    for (int m = 0; m < 4; ++m)
#pragma unroll
      for (int n = 0; n < 4; ++n) *(f32x4*)(part + (size_t)(prow0 + m * 16 + fr) * 1024 + col0 + n * 16 + fq * 4) = acc[m][n];
  }
}

namespace pg8 {
#define PG8_LAS __attribute__((address_space(3)))
using ::bf16_t; using ::bf16x8; using ::f32x4; using ::u32x4;
constexpr int BM = 256, BK = 64, HALF = 128, HTB = HALF * BK * 2  , STAGE_BYTES = 8 * HTB, NXCD = 8, WGM = 8;

__host__ __device__ __forceinline__ int lds_byte(int r, int c) { const int st = (r >> 4) * 2 + (c >> 5), rr = r & 15, cc = c & 31, ob = rr * 64 + cc * 2; return st * 1024 + (ob ^ (((ob >> 9) & 1) << 5)); }
__host__ __device__ __forceinline__ void stage_rc(int b, int& R, int& C) { const int st = b / 1024, sb = b % 1024, swz = sb ^ (((sb >> 9) & 1) << 5); R = (st >> 1) * 16 + swz / 64; C = (st & 1) * 32 + (swz % 64) / 2; }
__host__ __device__ __forceinline__ int perm32(int rho) { const int n = rho >> 4, i = rho & 15; return 8 * (i >> 2) + 4 * n + (i & 3); }

struct Unit { int pm, pn; };
struct Gemm { const bf16_t* A; const bf16_t* Bt; int M, N, K; };

struct StaticOrder {
    int nM, nN, nwg, G, c;
    __host__ __device__ void init(int M, int N, int G_, int c_) { nM = M / BM; nN = N / BM; nwg = nM * nN; G = G_; c = c_; }
    __host__ __device__ bool next(int i, Unit& u) const {
        const long L = (long)i * G + c; if (L >= nwg) return false;
        int wgid = (int)L; { const int q = nwg / NXCD, r = nwg % NXCD, xcd = wgid % NXCD, off = wgid / NXCD; wgid = (xcd < r ? xcd * (q + 1) : r * (q + 1) + (xcd - r) * q) + off; }
        const int nig = WGM * nN, gid = wgid / nig, fm = gid * WGM, gsz = (nM - fm) < WGM ? (nM - fm) : WGM;
        u.pm = fm + ((wgid % nig) % gsz); u.pn = (wgid % nig) / gsz; return true;
    }
    __device__ __forceinline__ void a_ready(const Unit&) const {}
    __device__ __forceinline__ void done(const Unit&) const {}
};

template <class Epi, class Sched, bool ALIGN_EPI = false, bool SP2 = false>
__device__ __forceinline__ void gemm_phase(PG8_LAS unsigned char* lds, const Gemm g, const Sched& S, const Epi& E, const int tid) {
    const int wid = __builtin_amdgcn_readfirstlane(tid >> 6), lane = tid & 63, wr = wid >> 2, wc = wid & 3, fr = lane & 15, fq = lane >> 4;
    const int K = g.K, nt = K / BK;
    unsigned voffA[2], voffB[2];
#pragma unroll
    for (int i = 0; i < 2; ++i) { int R, C; stage_rc(tid * 16 + i * 8192, R, C); const int Rb = Epi::PERM ? ((R & ~31) + perm32(R & 31)) : R;
        voffA[i] = (unsigned)(R * K + C) * 2u; voffB[i] = (unsigned)(Rb * K + C) * 2u; }
    const size_t kstep = (size_t)(BK * 2);
    const size_t hstep = (size_t)HALF * K * 2;
    const size_t tstep = 2 * hstep;
    const unsigned ldsw = (unsigned)wid * 1024u;
    const int aoff = lds_byte(wr * 64 + fr, fq * 8), boff = lds_byte(wc * 32 + fr, fq * 8);
#define PG8_SA(b, h) (((b) * 2 + (h)) * HTB)
#define PG8_SB(b, h) ((4 + (b) * 2 + (h)) * HTB)
#define PG8_STAGE(bufoff, gbase, voff) do { _Pragma("unroll") for (int _i = 0; _i < 2; ++_i) \
        __builtin_amdgcn_global_load_lds((const unsigned*)((const char*)(gbase) + (voff)[_i]), (PG8_LAS unsigned*)(lds + (bufoff) + ldsw + _i * 8192), 16, 0, 0); } while (0)
#define PG8_LDA(dst, b, h) do { _Pragma("unroll") for (int m = 0; m < 4; ++m) _Pragma("unroll") for (int k = 0; k < 2; ++k) dst[m][k] = *(const PG8_LAS bf16x8*)(lds + PG8_SA(b, h) + aoff + m * 2048 + k * 1024); } while (0)
#define PG8_LDB(dst, b, h) do { _Pragma("unroll") for (int n = 0; n < 2; ++n) _Pragma("unroll") for (int k = 0; k < 2; ++k) dst[n][k] = *(const PG8_LAS bf16x8*)(lds + PG8_SB(b, h) + boff + n * 2048 + k * 1024); } while (0)
#define PG8_MMA(ai, bj, At, Bt) do { __builtin_amdgcn_s_setprio(1); _Pragma("unroll") for (int m = 0; m < 4; ++m) _Pragma("unroll") for (int n = 0; n < 2; ++n) _Pragma("unroll") for (int k = 0; k < 2; ++k) \
        acc[ai][bj][m][n] = __builtin_amdgcn_mfma_f32_16x16x32_bf16(Bt[n][k], At[m][k], acc[ai][bj][m][n], 0, 0, 0); __builtin_amdgcn_s_setprio(0); } while (0)
#define PG8_WAIT_V(n) asm volatile("s_waitcnt vmcnt(" #n ")" ::: "memory")
#define PG8_WAIT_L(n) asm volatile("s_waitcnt lgkmcnt(" #n ")" ::: "memory")
#define PG8_BAR __builtin_amdgcn_s_barrier()
#define PG8_SCHED __builtin_amdgcn_sched_barrier(0)
    Unit cur, nxt; int ui = 0;
    if (!S.next(0, cur)) return;
    f32x4 acc[2][2][4][2];
#pragma unroll
    for (int a = 0; a < 2; ++a)
#pragma unroll
        for (int b = 0; b < 2; ++b)
#pragma unroll
            for (int m = 0; m < 4; ++m)
#pragma unroll
                for (int n = 0; n < 2; ++n) acc[a][b][m][n] = (f32x4){0.f, 0.f, 0.f, 0.f};
    bf16x8 At[4][2], B0[2][2], B1[2][2];
    const char* cA = (const char*)g.A + (size_t)cur.pm * tstep; const char* cB = (const char*)g.Bt + (size_t)cur.pn * tstep;
    S.a_ready(cur);
    if constexpr (SP2) {
        PG8_STAGE(PG8_SB(0, 0), cB, voffB); PG8_STAGE(PG8_SB(0, 1), cB + hstep, voffB); PG8_STAGE(PG8_SA(0, 0), cA, voffA); PG8_STAGE(PG8_SA(0, 1), cA + hstep, voffA);
        if (wr == 1) PG8_BAR;
        PG8_WAIT_V(2); PG8_BAR;
        PG8_STAGE(PG8_SB(1, 0), cB + kstep, voffB); PG8_STAGE(PG8_SA(1, 0), cA + kstep, voffA); PG8_STAGE(PG8_SB(1, 1), cB + hstep + kstep, voffB);
        PG8_WAIT_V(6); PG8_BAR;
    } else {
        PG8_STAGE(PG8_SB(0, 0), cB, voffB); PG8_STAGE(PG8_SA(0, 0), cA, voffA); PG8_STAGE(PG8_SB(0, 1), cB + hstep, voffB); PG8_STAGE(PG8_SA(0, 1), cA + hstep, voffA);
        if (wr == 1) PG8_BAR;
        PG8_WAIT_V(4); PG8_BAR;
        PG8_STAGE(PG8_SB(1, 0), cB + kstep, voffB); PG8_STAGE(PG8_SA(1, 0), cA + kstep, voffA); PG8_STAGE(PG8_SB(1, 1), cB + hstep + kstep, voffB);
        PG8_WAIT_V(6); PG8_BAR;
    }
    for (;;) {
        const bool has_next = S.next(ui + 1, nxt);
        const char* nA = has_next ? (const char*)g.A + (size_t)nxt.pm * tstep : cA; const char* nB = has_next ? (const char*)g.Bt + (size_t)nxt.pn * tstep : cB;
        for (int t = 0; t < nt; t += 2) {
            const bool last = (t == nt - 2);
            const char* a1 = cA + (size_t)(t + 1) * kstep;
            const char* a2 = last ? nA : cA + (size_t)(t + 2) * kstep; const char* b2 = last ? nB : cB + (size_t)(t + 2) * kstep;
            const char* a3 = a2 + kstep; const char* b3 = b2 + kstep;
            if (last && has_next) S.a_ready(nxt);
            if constexpr (SP2) {
            PG8_LDB(B0, 0, 0); PG8_LDB(B1, 0, 1); PG8_SCHED; PG8_LDA(At, 0, 0); PG8_STAGE(PG8_SA(1, 1), a1 + hstep, voffA);
            PG8_WAIT_V(8); PG8_WAIT_L(0); PG8_BAR; PG8_MMA(0, 0, At, B0); PG8_MMA(0, 1, At, B1); PG8_BAR; PG8_SCHED;
            PG8_LDA(At, 0, 1); PG8_STAGE(PG8_SB(0, 0), b2, voffB); PG8_STAGE(PG8_SB(0, 1), b2 + hstep, voffB); PG8_STAGE(PG8_SA(0, 0), a2, voffA);
            PG8_WAIT_V(8); PG8_WAIT_L(0); PG8_BAR; PG8_MMA(1, 0, At, B0); PG8_MMA(1, 1, At, B1); PG8_BAR; PG8_SCHED;
            PG8_LDB(B0, 1, 0); PG8_LDB(B1, 1, 1); PG8_SCHED; PG8_LDA(At, 1, 0); PG8_STAGE(PG8_SA(0, 1), a2 + hstep, voffA);
            PG8_WAIT_V(8); PG8_WAIT_L(0); PG8_BAR; PG8_MMA(0, 0, At, B0); PG8_MMA(0, 1, At, B1); PG8_BAR; PG8_SCHED;
            PG8_LDA(At, 1, 1); PG8_STAGE(PG8_SB(1, 0), b3, voffB); PG8_STAGE(PG8_SB(1, 1), b3 + hstep, voffB); PG8_STAGE(PG8_SA(1, 0), a3, voffA);
            PG8_WAIT_V(8); PG8_WAIT_L(0); PG8_BAR; PG8_MMA(1, 0, At, B0); PG8_MMA(1, 1, At, B1); PG8_BAR; PG8_SCHED;
            } else {
            PG8_LDB(B0, 0, 0); PG8_SCHED; PG8_LDA(At, 0, 0); PG8_STAGE(PG8_SA(1, 1), a1 + hstep, voffA);
            PG8_WAIT_L(8); PG8_BAR; PG8_WAIT_L(0); PG8_MMA(0, 0, At, B0); PG8_BAR; PG8_SCHED;
            PG8_LDB(B1, 0, 1); PG8_STAGE(PG8_SB(0, 0), b2, voffB);
            PG8_BAR; PG8_WAIT_L(0); PG8_MMA(0, 1, At, B1); PG8_BAR;
            PG8_LDA(At, 0, 1); PG8_STAGE(PG8_SA(0, 0), a2, voffA);
            PG8_BAR; PG8_WAIT_L(0); PG8_MMA(1, 0, At, B0); PG8_BAR; PG8_SCHED;
            PG8_STAGE(PG8_SB(0, 1), b2 + hstep, voffB);
            PG8_WAIT_V(6); PG8_BAR; PG8_MMA(1, 1, At, B1); PG8_BAR;
            PG8_LDB(B0, 1, 0); PG8_SCHED; PG8_LDA(At, 1, 0); PG8_STAGE(PG8_SA(0, 1), a2 + hstep, voffA);
            PG8_WAIT_L(8); PG8_BAR; PG8_WAIT_L(0); PG8_MMA(0, 0, At, B0); PG8_BAR; PG8_SCHED;
            PG8_LDB(B1, 1, 1); PG8_STAGE(PG8_SB(1, 0), b3, voffB);
            PG8_BAR; PG8_WAIT_L(0); PG8_MMA(0, 1, At, B1); PG8_BAR;
            PG8_LDA(At, 1, 1); PG8_STAGE(PG8_SA(1, 0), a3, voffA);
            PG8_BAR; PG8_WAIT_L(0); PG8_MMA(1, 0, At, B0); PG8_BAR; PG8_SCHED;
            PG8_STAGE(PG8_SB(1, 1), b3 + hstep, voffB);
            PG8_WAIT_V(6); PG8_BAR; PG8_MMA(1, 1, At, B1); PG8_BAR;
            }
        }
        if constexpr (ALIGN_EPI) { if (wr == 0) PG8_BAR; }
        if constexpr (!Epi::AFTER_DRAIN) { E(acc, cur, wr, wc, fr, fq); S.done(cur); }
        if (!has_next) break;
#pragma unroll
        for (int a = 0; a < 2; ++a)
#pragma unroll
            for (int b = 0; b < 2; ++b)
#pragma unroll
                for (int m = 0; m < 4; ++m)
#pragma unroll
                    for (int n = 0; n < 2; ++n) acc[a][b][m][n] = (f32x4){0.f, 0.f, 0.f, 0.f};
        cur = nxt; cA = nA; cB = nB; ++ui;
        if constexpr (ALIGN_EPI) { if (wr == 1) PG8_BAR; }
    }
    PG8_WAIT_V(0);
    if constexpr (!ALIGN_EPI) { if (wr == 0) PG8_BAR; }
    PG8_BAR;
    if constexpr (Epi::AFTER_DRAIN) { E.fused(acc, cur, wr, wc, fr, fq, lds, wid, lane); S.done(cur); }
#undef PG8_SA
#undef PG8_SB
#undef PG8_STAGE
#undef PG8_LDA
#undef PG8_LDB
#undef PG8_MMA
#undef PG8_WAIT_V
#undef PG8_WAIT_L
#undef PG8_BAR
#undef PG8_SCHED
}
}


struct EpiResid {
  static constexpr bool PERM = false, AFTER_DRAIN = false;
  float* hres; const float* modl; int goff;
  __device__ __forceinline__ void operator()(const f32x4 (&acc)[2][2][4][2], const pg8::Unit& u, int wr, int wc, int fr_, int fq_) const {
    int fr = fr_, fq = fq_; asm volatile("" : "+v"(fr), "+v"(fq));
    const int row0 = u.pm * 256 + wr * 64 + fr, col0 = u.pn * 256 + wc * 32 + 4 * fq;
    const float* gm = modl + (u.pm < 32 ? 0 : (u.pm < 64 ? 1 : 2)) * 6144 + goff;
#pragma unroll
    for (int bj = 0; bj < 2; ++bj)
#pragma unroll
      for (int n = 0; n < 2; ++n) {
        const int col = col0 + bj * 128 + n * 16;
        const f32x4 g = *(const f32x4*)(gm + col);
#pragma unroll
        for (int ai = 0; ai < 2; ++ai)
#pragma unroll
          for (int m = 0; m < 4; ++m) {
            f32x4* hp = (f32x4*)(hres + (size_t)(row0 + ai * 128 + m * 16) * 1024 + col);
            *hp = *hp + g * acc[ai][bj][m][n];
          }
        asm volatile("" ::: "memory");
      }
  }
};
struct EpiSwiglu {
  static constexpr bool PERM = false, AFTER_DRAIN = false;
  bf16_t* hm;
  __device__ __forceinline__ void operator()(const f32x4 (&acc)[2][2][4][2], const pg8::Unit& u, int wr, int wc, int fr_, int fq_) const {
    int fr = fr_, fq = fq_; asm volatile("" : "+v"(fr), "+v"(fq));
    const int row0 = u.pm * 256 + wr * 64 + fr, hid0 = u.pn * 128 + wc * 16 + 4 * fq;
#pragma unroll
    for (int ai = 0; ai < 2; ++ai)
#pragma unroll
      for (int m = 0; m < 4; ++m)
#pragma unroll
        for (int bj = 0; bj < 2; ++bj) {
          const f32x4 a = acc[ai][bj][m][0], g = acc[ai][bj][m][1];
          u32x2 w; w.x = pk2(siluf(a.x) * g.x, siluf(a.y) * g.y); w.y = pk2(siluf(a.z) * g.z, siluf(a.w) * g.w);
          *(u32x2*)(hm + (size_t)(row0 + ai * 128 + m * 16) * FFH + hid0 + bj * 64) = w;
        }
  }
};
struct EpiInproj {
  static constexpr bool PERM = false, AFTER_DRAIN = false;
  unsigned char* ws; const float *qg, *kg;
  __device__ __forceinline__ void operator()(const f32x4 (&acc)[2][2][4][2], const pg8::Unit& u, int wr, int wc, int fr_, int fq_) const {
    int fr = fr_, fq = fq_; asm volatile("" : "+v"(fr), "+v"(fq));
    const int pn = u.pn, pm = u.pm;
    const bool isctx = pm >= 64;
    const int b = isctx ? pm - 64 : pm >> 5;
    const int rowb = pm * 256 + wr * 64 + fr;
#ifndef EB
#define EB 15
#endif
    if ((EB & 1) && (pn < 2 || (pn == 2 && wc < 2))) {
      const bool isq = pn < 2;
      const float* g = isq ? qg : kg;
      const float sc = isq ? 0.125f * 1.4426950408889634f : 1.f;
#pragma unroll
      for (int ai = 0; ai < 2; ++ai)
#pragma unroll
        for (int m = 0; m < 4; ++m) {
          const int row = rowb + ai * 128 + m * 16;
          float ss = 0.f;
#pragma unroll
          for (int bj = 0; bj < 2; ++bj)
#pragma unroll
            for (int n = 0; n < 2; ++n) { const f32x4 x = acc[ai][bj][m][n]; ss += x.x * x.x + x.y * x.y + x.z * x.z + x.w * x.w; }
          ss += __shfl_xor(ss, 16); ss += __shfl_xor(ss, 32);
          const float rstd = rsqrtf(ss * (1.f / 64.f) + EPS);
          const int pos = isctx ? (row & 255) : (row & 8191), tok = isctx ? 8192 + pos : pos;
          bf16_t* dst = isq ? (bf16_t*)(ws + OFF_Q) + (size_t)row * 512 + (pn * 4 + wc) * 64 : (bf16_t*)(ws + OFF_K) + ((size_t)(b * 2 + wc) * NKEY + tok) * 64;
#pragma unroll
          for (int bj = 0; bj < 2; ++bj) {
            const int d0 = 16 * bj + 4 * fq;
            f32x4 x0 = acc[ai][bj][m][0] * rstd * *(const f32x4*)(g + d0), x1 = acc[ai][bj][m][1] * rstd * *(const f32x4*)(g + 32 + d0);
            if (!isctx) {
              const f32x4* rt = (const f32x4*)((const float2*)(ws + OFF_ROPE) + (size_t)pos * 32 + d0);
              const f32x4 cs0 = rt[0], cs1 = rt[1];
              const f32x4 c = (f32x4){cs0.x, cs0.z, cs1.x, cs1.z}, sn = (f32x4){cs0.y, cs0.w, cs1.y, cs1.w};
              const f32x4 y0 = x0 * c - x1 * sn, y1 = x0 * sn + x1 * c;
              x0 = y0; x1 = y1;
            }
            x0 = x0 * sc; x1 = x1 * sc;
            u32x2 w0, w1; w0.x = pk2(x0.x, x0.y); w0.y = pk2(x0.z, x0.w); w1.x = pk2(x1.x, x1.y); w1.y = pk2(x1.z, x1.w);
            *(u32x2*)(dst + d0) = w0; *(u32x2*)(dst + 32 + d0) = w1;
          }
        }
    } else if ((EB & 2) && pn < 6) {
      bf16_t* base = pn == 2 ? (bf16_t*)(ws + OFF_VT) + ((size_t)(b * 2 + (wc - 2)) * 64) * NKEY : (bf16_t*)(ws + OFF_HYP) + ((size_t)b * 768 + (pn - 3) * 256 + wc * 64) * NKEY;
#pragma unroll
      for (int ai = 0; ai < 2; ++ai)
#pragma unroll
        for (int m = 0; m < 4; ++m) {
          const int row = rowb + ai * 128 + m * 16;
          const int tok = isctx ? 8192 + (row & 255) : (row & 8191);
#pragma unroll
          for (int bj = 0; bj < 2; ++bj)
#pragma unroll
            for (int n = 0; n < 2; ++n) {
              const f32x4 x = acc[ai][bj][m][n];
              bf16_t* dp = base + (size_t)(32 * n + 16 * bj + 4 * fq) * NKEY + tok;
              dp[0] = f2bf(x.x); dp[NKEY] = f2bf(x.y); dp[2 * NKEY] = f2bf(x.z); dp[3 * NKEY] = f2bf(x.w);
              asm volatile("" ::: "memory");
            }
        }
    } else if ((EB & 4) && pn < 9) {
      float* base; int ld; float sc = 1.f;
      if (pn == 6) { ld = 128; if (wc < 2) { base = (float*)(ws + OFF_GQ) + wc * 64; sc = 0.17677669529663687f; } else base = (float*)(ws + OFF_GK) + (wc - 2) * 64; }
      else { ld = 256; base = (float*)(ws + (pn == 7 ? OFF_GV : OFF_GR)) + wc * 64; }
#pragma unroll
      for (int ai = 0; ai < 2; ++ai)
#pragma unroll
        for (int m = 0; m < 4; ++m) {
          const int row = rowb + ai * 128 + m * 16;
#pragma unroll
          for (int bj = 0; bj < 2; ++bj)
#pragma unroll
            for (int n = 0; n < 2; ++n) *(f32x4*)(base + (size_t)row * ld + 32 * n + 16 * bj + 4 * fq) = acc[ai][bj][m][n] * sc;
          asm volatile("" ::: "memory");
        }
    } else if (wc == 0) {
      float* base = (float*)(ws + OFF_LR) + 4 * fq;
#pragma unroll
      for (int ai = 0; ai < 2; ++ai)
#pragma unroll
        for (int m = 0; m < 4; ++m) {
          const int row = rowb + ai * 128 + m * 16;
          *(f32x4*)(base + (size_t)row * 32) = acc[ai][0][m][0]; *(f32x4*)(base + (size_t)row * 32 + 16) = acc[ai][0][m][1];
        }
    }
  }
};

template <int NG, bool SHIFT>
DI void attn_tile(const bf16_t* ks, const bf16_t* vs, const bf16x8 (&qf)[NG][4], f32x16 (&o0)[NG], f32x16 (&o1)[NG], float (&lsum)[NG], const f32x16& cinit, int l31, int h) {
  bf16x8 pf[NG][4];
#pragma unroll
  for (int half = 0; half < 2; ++half) {
    f32x16 sv[NG];
#pragma unroll
    for (int s = 0; s < 4; ++s) {
      const bf16x8 a0 = *(const bf16x8*)(ks + (32 * half + l31) * 72 + 16 * s + 8 * h);
#pragma unroll
      for (int g = 0; g < NG; ++g) {
        if (s == 0) {
          if (SHIFT) sv[g] = MFMA32(a0, qf[g][s], cinit);
          else { f32x16 z; for (int i = 0; i < 16; ++i) z[i] = 0.f; sv[g] = MFMA32(a0, qf[g][s], z); }
        } else sv[g] = MFMA32(a0, qf[g][s], sv[g]);
      }
    }
#pragma unroll
    for (int g = 0; g < NG; ++g) {
      float ps = 0.f;
#pragma unroll
      for (int i = 0; i < 16; ++i) { sv[g][i] = __builtin_amdgcn_exp2f(sv[g][i]); ps += sv[g][i]; }
      lsum[g] += ps;
      u32x4 pw;
      pw.x = pk2(sv[g][0], sv[g][1]); pw.y = pk2(sv[g][2], sv[g][3]); pw.z = pk2(sv[g][4], sv[g][5]); pw.w = pk2(sv[g][6], sv[g][7]); pf[g][2 * half] = __builtin_bit_cast(bf16x8, pw);
      pw.x = pk2(sv[g][8], sv[g][9]); pw.y = pk2(sv[g][10], sv[g][11]); pw.z = pk2(sv[g][12], sv[g][13]); pw.w = pk2(sv[g][14], sv[g][15]); pf[g][2 * half + 1] = __builtin_bit_cast(bf16x8, pw);
    }
    asm volatile("" ::: "memory");
  }
#pragma unroll
  for (int kk = 0; kk < 4; ++kk) {
    const int kb = 16 * kk + 4 * h;
    const s16x4 lo0 = *(const s16x4*)(vs + l31 * 68 + kb), hi0 = *(const s16x4*)(vs + l31 * 68 + kb + 8);
    const s16x4 lo1 = *(const s16x4*)(vs + (32 + l31) * 68 + kb), hi1 = *(const s16x4*)(vs + (32 + l31) * 68 + kb + 8);
    const bf16x8 v0 = __builtin_shufflevector(lo0, hi0, 0, 1, 2, 3, 4, 5, 6, 7), v1 = __builtin_shufflevector(lo1, hi1, 0, 1, 2, 3, 4, 5, 6, 7);
#pragma unroll
    for (int g = 0; g < NG; ++g) { o0[g] = MFMA32(v0, pf[g][kk], o0[g]); o1[g] = MFMA32(v1, pf[g][kk], o1[g]); }
  }
}

DI float attn_score_bound(const Params& p, int layer, int lane) {
  float mq = fabsf(p.q_norm_g[layer * 64 + lane]), mk = fabsf(p.k_norm_g[layer * 64 + lane]);
#pragma unroll
  for (int o = 1; o < 64; o <<= 1) { mq = fmaxf(mq, __shfl_xor(mq, o)); mk = fmaxf(mk, __shfl_xor(mk, o)); }
  return (64.f * mq * mk * (0.125f * 1.4426950408889634f)) * 1.001f;
}

template <int NG, bool SHIFT>
DI void attn_unit(const Params& p, unsigned char* lds, int layer, int b, int head, int qrow0, int key0, int nkeys, float cbound, int tid) {
  unsigned char* ws = p.ws;
  const int lane = tid & 63, wave = tid >> 6, l31 = lane & 31, h = lane >> 5, kvh = head >> 2;
  const bf16_t* Kg = (const bf16_t*)(ws + OFF_K) + ((size_t)(b * 2 + kvh) * NKEY + key0) * 64;
  const bf16_t* Vg = (const bf16_t*)(ws + OFF_VT) + ((size_t)(b * 2 + kvh) * 64) * NKEY + key0;
  bf16_t* Ks = (bf16_t*)lds;
  bf16_t* Vs = (bf16_t*)(lds + 18432);
  const int qrowb = qrow0 + wave * (32 * NG) + l31;
  bf16x8 qf[NG][4];
#pragma unroll
  for (int g = 0; g < NG; ++g)
#pragma unroll
    for (int s = 0; s < 4; ++s) qf[g][s] = *(const bf16x8*)((const bf16_t*)(ws + OFF_Q) + (size_t)(qrowb + 32 * g) * 512 + head * 64 + 16 * s + 8 * h);
  f32x16 o0[NG], o1[NG]; float lsum[NG];
#pragma unroll
  for (int g = 0; g < NG; ++g) {
    lsum[g] = 0.f;
#pragma unroll
    for (int i = 0; i < 16; ++i) { o0[g][i] = 0.f; o1[g][i] = 0.f; }
  }
  f32x16 cinit;
#pragma unroll
  for (int i = 0; i < 16; ++i) cinit[i] = SHIFT ? -cbound : 0.f;
  const int ntile = nkeys >> 6, lr = tid >> 3, lc = tid & 7;
#define ATT_LD(kr, vr, t) do { kr = *(const u32x4*)(Kg + (size_t)((t) * 64 + lr) * 64 + lc * 8); vr = *(const u32x4*)(Vg + (size_t)lr * NKEY + (t) * 64 + lc * 8); } while (0)
#define ATT_ST(buf, kr, vr) do { *(u32x4*)(Ks + (buf) * (64 * 72) + lr * 72 + lc * 8) = kr; *(u32x2*)(Vs + (buf) * (64 * 68) + lr * 68 + lc * 8) = (u32x2){vr.x, vr.y}; \
    *(u32x2*)(Vs + (buf) * (64 * 68) + lr * 68 + lc * 8 + 4) = (u32x2){vr.z, vr.w}; } while (0)
#define ATT_BAR() do { asm volatile("s_waitcnt lgkmcnt(0)" ::: "memory"); __builtin_amdgcn_s_barrier(); asm volatile("" ::: "memory"); } while (0)
  u32x4 kr, vr;
  ATT_LD(kr, vr, 0);
  __syncthreads();
  ATT_ST(0, kr, vr);
  if (ntile > 1) ATT_LD(kr, vr, 1);
  ATT_BAR();
#pragma unroll 1
  for (int t = 0; t < ntile; ++t) {
    const int cur = t & 1;
    attn_tile<NG, SHIFT>(Ks + cur * (64 * 72), Vs + cur * (64 * 68), qf, o0, o1, lsum, cinit, l31, h);
    if (t + 1 < ntile) { ATT_ST(cur ^ 1, kr, vr); if (t + 2 < ntile) ATT_LD(kr, vr, t + 2); }
    ATT_BAR();
  }
#undef ATT_LD
#undef ATT_ST
#undef ATT_BAR
  const float* gn = p.out_norm_g + layer * 1024 + head * 64;
#pragma unroll
  for (int g = 0; g < NG; ++g) {
    const float ltot = lsum[g] + __shfl_xor(lsum[g], 32), inv = 1.f / ltot;
    float ss = 0.f;
#pragma unroll
    for (int i = 0; i < 16; ++i) { o0[g][i] *= inv; o1[g][i] *= inv; ss += o0[g][i] * o0[g][i] + o1[g][i] * o1[g][i]; }
    ss += __shfl_xor(ss, 32);
    const float rstd = rsqrtf(ss * (1.f / 64.f) + EPS);
    bf16_t* dst = (bf16_t*)(ws + OFF_U) + (size_t)(qrowb + 32 * g) * 1024 + head * 64;
#pragma unroll
    for (int i4 = 0; i4 < 4; ++i4) {
      const int d = 8 * i4 + 4 * h;
      const f32x4 g0 = *(const f32x4*)(gn + d), g1 = *(const f32x4*)(gn + 32 + d);
      u32x2 w0, w1;
      w0.x = pk2(o0[g][4 * i4] * rstd * g0.x, o0[g][4 * i4 + 1] * rstd * g0.y); w0.y = pk2(o0[g][4 * i4 + 2] * rstd * g0.z, o0[g][4 * i4 + 3] * rstd * g0.w);
      w1.x = pk2(o1[g][4 * i4] * rstd * g1.x, o1[g][4 * i4 + 1] * rstd * g1.y); w1.y = pk2(o1[g][4 * i4 + 2] * rstd * g1.z, o1[g][4 * i4 + 3] * rstd * g1.w);
      *(u32x2*)(dst + d) = w0; *(u32x2*)(dst + 32 + d) = w1;
    }
  }
}

DI float hy_sc(const bf16_t* prow, int t, int n, float w0, float w1, float w2, float bias) {
  const float xm = t > 0 ? bf2f(prow[t - 1]) : 0.f, x0 = bf2f(prow[t]), xp = t + 1 < n ? bf2f(prow[t + 1]) : 0.f;
  return w0 * xm + w1 * x0 + w2 * xp + bias;
}

DI void hyena_lat_item(const Params& p, unsigned char* lds, int layer, int b, int pr, int tid) {
  unsigned char* ws = p.ws;
  float2* buf = (float2*)lds;
  const int ca = 2 * pr;
  const bf16_t* hyp = (const bf16_t*)(ws + OFF_HYP) + (size_t)b * 768 * NKEY;
  const float* cw = p.hy_conv_w + (size_t)layer * 3 * 768; const float* cbias = p.hy_conv_b + (size_t)layer * 768;
  const float* hb = p.hy_bias + (size_t)layer * 512;
  float w[3][2][4];
#pragma unroll
  for (int s = 0; s < 3; ++s)
#pragma unroll
    for (int e = 0; e < 2; ++e) { const int c = s * 256 + ca + e; w[s][e][0] = cw[c]; w[s][e][1] = cw[768 + c]; w[s][e][2] = cw[1536 + c]; w[s][e][3] = cbias[c]; }
  const bf16_t* pv0 = hyp + (size_t)(ca) * NKEY; const bf16_t* pv1 = hyp + (size_t)(ca + 1) * NKEY;
  const bf16_t* p10 = hyp + (size_t)(256 + ca) * NKEY; const bf16_t* p11 = hyp + (size_t)(256 + ca + 1) * NKEY;
  const bf16_t* p20 = hyp + (size_t)(512 + ca) * NKEY; const bf16_t* p21 = hyp + (size_t)(512 + ca + 1) * NKEY;
  float* outa = (float*)(ws + OFF_HYRAW) + ((size_t)b * 256 + ca) * NKEY; float* outb = outa + NKEY;
  const float b0a = hb[ca], b0b = hb[ca + 1], b1a = hb[256 + ca], b1b = hb[256 + ca + 1];
  __syncthreads();
#define HY_FENCE(i) do { if (((i) & 3) == 3) asm volatile("" ::: "memory"); } while (0)
  float2 vv[16];
#pragma unroll
  for (int i = 0; i < 16; ++i) {
    const int t = tid + NT * i;
    vv[i] = make_float2(hy_sc(pv0, t, 8192, w[0][0][0], w[0][0][1], w[0][0][2], w[0][0][3]), hy_sc(pv1, t, 8192, w[0][1][0], w[0][1][1], w[0][1][2], w[0][1][3]));
    buf[t] = vv[i]; buf[8192 + t] = make_float2(0.f, 0.f);
    HY_FENCE(i);
  }
  __syncthreads();
  SpecRegs sr;
  spec_load(sr, (const float4*)(ws + OFF_SPEC) + (size_t)(0 * 128 + pr) * 8193, tid);
  fft_fwd(buf, tid);
  spec_mul(buf, sr, tid);
  float2 xg[16];
#pragma unroll
  for (int i = 0; i < 16; ++i) {
    const int t = tid + NT * i;
    xg[i] = make_float2(hy_sc(p10, t, 8192, w[1][0][0], w[1][0][1], w[1][0][2], w[1][0][3]), hy_sc(p11, t, 8192, w[1][1][0], w[1][1][1], w[1][1][2], w[1][1][3]));
    HY_FENCE(i);
  }
  fft_inv(buf, tid);
#pragma unroll
  for (int i = 0; i < 16; ++i) {
    const int t = tid + NT * i;
    const float2 y = buf[t];
    vv[i] = make_float2(xg[i].x * (y.x * (1.f / 16384.f) + vv[i].x * b0a), xg[i].y * (y.y * (1.f / 16384.f) + vv[i].y * b0b));
    buf[t] = vv[i]; buf[8192 + t] = make_float2(0.f, 0.f);
  }
  __syncthreads();
  spec_load(sr, (const float4*)(ws + OFF_SPEC) + (size_t)(1 * 128 + pr) * 8193, tid);
  fft_fwd(buf, tid);
  spec_mul(buf, sr, tid);
#pragma unroll
  for (int i = 0; i < 16; ++i) {
    const int t = tid + NT * i;
    xg[i] = make_float2(hy_sc(p20, t, 8192, w[2][0][0], w[2][0][1], w[2][0][2], w[2][0][3]), hy_sc(p21, t, 8192, w[2][1][0], w[2][1][1], w[2][1][2], w[2][1][3]));
    HY_FENCE(i);
  }
  fft_inv(buf, tid);
#pragma unroll
  for (int i = 0; i < 16; ++i) {
    const int t = tid + NT * i;
    const float2 y = buf[t];
    outa[t] = xg[i].x * (y.x * (1.f / 16384.f) + vv[i].x * b1a);
    outb[t] = xg[i].y * (y.y * (1.f / 16384.f) + vv[i].y * b1b);
  }
#undef HY_FENCE
  __syncthreads();
}

DI void hyena_ctx_item(const Params& p, unsigned char* lds, int layer, int b, int pr, int tid) {
  unsigned char* ws = p.ws;
  float* lf = (float*)lds;
  const int cs = tid >> 8, t = tid & 255, c = 2 * pr + cs;
  float* vv = lf + cs * 256; float* zz = lf + 512 + cs * 256;
  float* hp0 = lf + 1024 + cs * 256; float* hn0 = lf + 1536 + cs * 256; float* hp1 = lf + 2048 + cs * 256; float* hn1 = lf + 2560 + cs * 256;
  const bf16_t* hyp = (const bf16_t*)(ws + OFF_HYP) + (size_t)b * 768 * NKEY + 8192;
  const float* cw = p.hy_conv_w + (size_t)layer * 3 * 768; const float* cbias = p.hy_conv_b + (size_t)layer * 768;
  const float* hb = p.hy_bias + (size_t)layer * 512;
  const float* hc = (const float*)(ws + OFF_HC) + (size_t)t * 1024;
  const float uv = hy_sc(hyp + (size_t)c * NKEY, t, 256, cw[c], cw[768 + c], cw[1536 + c], cbias[c]);
  const float x1 = hy_sc(hyp + (size_t)(256 + c) * NKEY, t, 256, cw[256 + c], cw[768 + 256 + c], cw[1536 + 256 + c], cbias[256 + c]);
  const float x2 = hy_sc(hyp + (size_t)(512 + c) * NKEY, t, 256, cw[512 + c], cw[768 + 512 + c], cw[1536 + 512 + c], cbias[512 + c]);
  __syncthreads();
  vv[t] = uv; hp0[t] = hc[c]; hn0[t] = hc[256 + c]; hp1[t] = hc[512 + c]; hn1[t] = hc[768 + c];
  __syncthreads();
  float y = 0.f;
  for (int s = 0; s < 256; ++s) y += (s <= t ? hp0[t - s] : hn0[s - t]) * vv[s];
  const float z = x1 * (y + hb[c] * uv);
  zz[t] = z;
  __syncthreads();
  float y2 = 0.f;
  for (int s = 0; s < 256; ++s) y2 += (s <= t ? hp1[t - s] : hn1[s - t]) * zz[s];
  ((float*)(ws + OFF_HYRAW))[((size_t)b * 256 + c) * NKEY + 8192 + t] = x2 * (y2 + hb[256 + c] * z);
  __syncthreads();
}

DI void hyena_norm_item(const Params& p, unsigned char* lds, int layer, int b, int tt, int tid) {
  unsigned char* ws = p.ws;
  float* tile = (float*)lds;
  float* ssb = tile + 256 * 65;
  const int lane = tid & 63, wave = tid >> 6;
  const float* src = (const float*)(ws + OFF_HYRAW) + (size_t)b * 256 * NKEY + tt * 64;
  __syncthreads();
#pragma unroll 4
  for (int i = 0; i < 32; ++i) { const int ch = i * 8 + wave; tile[ch * 65 + lane] = src[(size_t)ch * NKEY + lane]; }
  __syncthreads();
  float v[32]; float ss = 0.f;
#pragma unroll
  for (int j = 0; j < 32; ++j) { v[j] = tile[(wave * 32 + j) * 65 + lane]; ss += v[j] * v[j]; }
  ssb[wave * 64 + lane] = ss;
  __syncthreads();
  const float rstd = rsqrtf((ssb[(wave & ~1) * 64 + lane] + ssb[(wave | 1) * 64 + lane]) * (1.f / 64.f) + EPS);
  const int tok = tt * 64 + lane;
  const int row = tok < 8192 ? b * 8192 + tok : 16384 + b * 256 + (tok - 8192);
  const float* g = p.out_norm_g + layer * 1024 + 512 + wave * 32;
  bf16_t* dst = (bf16_t*)(ws + OFF_U) + (size_t)row * 1024 + 512 + wave * 32;
#pragma unroll
  for (int c8 = 0; c8 < 4; ++c8) {
    u32x4 w;
    w.x = pk2(v[c8 * 8] * rstd * g[c8 * 8], v[c8 * 8 + 1] * rstd * g[c8 * 8 + 1]); w.y = pk2(v[c8 * 8 + 2] * rstd * g[c8 * 8 + 2], v[c8 * 8 + 3] * rstd * g[c8 * 8 + 3]);
    w.z = pk2(v[c8 * 8 + 4] * rstd * g[c8 * 8 + 4], v[c8 * 8 + 5] * rstd * g[c8 * 8 + 5]); w.w = pk2(v[c8 * 8 + 6] * rstd * g[c8 * 8 + 6], v[c8 * 8 + 7] * rstd * g[c8 * 8 + 7]);
    *(u32x4*)(dst + c8 * 8) = w;
  }
}

DI float wave_scan_incl(float x, int lane) {
#pragma unroll
  for (int o = 1; o < 64; o <<= 1) { const float y = __shfl_up(x, o); if (lane >= o) x += y; }
  return x;
}
DI void gla_gates(const Params& p, int layer, const float* lr, int c, float& zf, float& zb) {
  const float* gw = p.gla_gate_w + (size_t)layer * 2 * 16 * 128 + c;
  float a = p.gla_gate_b[layer * 256 + c], b = p.gla_gate_b[layer * 256 + 128 + c];
#pragma unroll
  for (int r4 = 0; r4 < 4; ++r4) {
    const f32x4 lf = *(const f32x4*)(lr + r4 * 4), lb = *(const f32x4*)(lr + 16 + r4 * 4);
    a += lf.x * gw[(r4 * 4) * 128] + lf.y * gw[(r4 * 4 + 1) * 128] + lf.z * gw[(r4 * 4 + 2) * 128] + lf.w * gw[(r4 * 4 + 3) * 128];
    b += lb.x * gw[(16 + r4 * 4) * 128] + lb.y * gw[(16 + r4 * 4 + 1) * 128] + lb.z * gw[(16 + r4 * 4 + 2) * 128] + lb.w * gw[(16 + r4 * 4 + 3) * 128];
  }
  zf = log_sigmoid(a) * 0.0625f; zb = log_sigmoid(b) * 0.0625f;
}

DI int gla_row(int b, int sc, int i) { return sc < 128 ? b * 8192 + sc * 64 + i : 16384 + b * 256 + (sc - 128) * 64 + i; }

DI void gla_local_item(const Params& p, unsigned char* lds, int layer, int b, int sc, int h, int tid) {
  unsigned char* ws = p.ws;
  float* lf = (float*)lds;
  float* kt = lf;
  float* vs = lf + 2 * 64 * 33;
  float* lg = vs + 64 * 68;
  const int row0 = gla_row(b, sc, 0);
  const float* gk = (const float*)(ws + OFF_GK) + (size_t)row0 * 128 + h * 32;
  const float* gv = (const float*)(ws + OFF_GV) + (size_t)row0 * 256 + h * 64;
  const float* lr = (const float*)(ws + OFF_LR) + (size_t)row0 * 32;
  __syncthreads();
  {
    const int d = tid & 31, c = h * 32 + d;
    const float* gw = p.gla_gate_w + (size_t)layer * 2 * 16 * 128 + c;
    float gwf[16], gwb[16];
#pragma unroll
    for (int r = 0; r < 16; ++r) { gwf[r] = gw[r * 128]; gwb[r] = gw[(16 + r) * 128]; }
    const float bf_ = p.gla_gate_b[layer * 256 + c], bb_ = p.gla_gate_b[layer * 256 + 128 + c];
#pragma unroll
    for (int k = 0; k < 4; ++k) {
      const int i = (tid >> 5) + 16 * k;
      const float kk = gk[i * 128 + d]; kt[i * 33 + d] = kk; kt[64 * 33 + i * 33 + d] = kk;
      const f32x4* lp = (const f32x4*)(lr + i * 32);
      float a = bf_, bsum = bb_;
#pragma unroll
      for (int r4 = 0; r4 < 4; ++r4) {
        const f32x4 lf_ = lp[r4], lb_ = lp[4 + r4];
        a += lf_.x * gwf[r4 * 4] + lf_.y * gwf[r4 * 4 + 1] + lf_.z * gwf[r4 * 4 + 2] + lf_.w * gwf[r4 * 4 + 3];
        bsum += lb_.x * gwb[r4 * 4] + lb_.y * gwb[r4 * 4 + 1] + lb_.z * gwb[r4 * 4 + 2] + lb_.w * gwb[r4 * 4 + 3];
      }
      const float zf = log_sigmoid(a) * 0.0625f, zb = log_sigmoid(bsum) * 0.0625f;
      lg[i * 33 + d] = zf; lg[64 * 33 + i * 33 + d] = zb;
      ((float*)(ws + OFF_LGF))[(size_t)(row0 + i) * 128 + c] = zf; ((float*)(ws + OFF_LGB))[(size_t)(row0 + i) * 128 + c] = zb;
    }
  }
  for (int e = tid; e < 4096; e += NT) { const int i = e >> 6, d = e & 63; vs[i * 68 + d] = gv[i * 256 + d]; }
  __syncthreads();
  {
    const int lane = tid & 63, wave = tid >> 6, dir = wave >> 2;
    float* l = lg + dir * 64 * 33; float* k = kt + dir * 64 * 33;
#pragma unroll
    for (int dd = 0; dd < 8; ++dd) {
      const int d = (wave & 3) * 8 + dd;
      const float x = l[lane * 33 + d];
      const float pre = wave_scan_incl(x, lane), tot = __shfl(pre, 63);
      const float cum = dir == 0 ? pre : tot - pre + x;
      k[lane * 33 + d] *= __expf(tot - cum);
      if (lane == 0) ((float*)(ws + OFF_DEC))[(((size_t)(dir * 2 + b) * 4 + h) * 132 + sc) * 32 + d] = __expf(tot);
    }
  }
  __syncthreads();
  {
    const int lane = tid & 63, wave = tid >> 6, fr = lane & 15, fq = lane >> 4;
    const int dir = wave >> 2, tdk = (wave >> 1) & 1, tdv0 = (wave & 1) * 2;
    const float* ka = kt + dir * 64 * 33 + tdk * 16 + fr;
    const float* vb = vs + tdv0 * 16 + fr;
    f32x4 c0 = (f32x4){0.f, 0.f, 0.f, 0.f}, c1 = c0;
#pragma unroll 4
    for (int ks = 0; ks < 16; ++ks) {
      const int j = ks * 4 + fq;
      const float av = ka[j * 33], b0 = vb[j * 68], b1 = vb[j * 68 + 16];
      c0 = MFMA4F(av, b0, c0); c1 = MFMA4F(av, b1, c1);
    }
    float* dst = (float*)(ws + OFF_KV) + ((((size_t)(dir * 2 + b) * 4 + h) * 132 + sc) * 32 + tdk * 16 + fq * 4) * 64 + tdv0 * 16 + fr;
#pragma unroll
    for (int jj = 0; jj < 4; ++jj) { dst[jj * 64] = c0[jj]; dst[jj * 64 + 16] = c1[jj]; }
  }
}

DI void gla_scan(const Params& p, int tid) {
  unsigned char* ws = p.ws;
  for (int blk = bidx(); blk < 64; blk += gdim()) {
    const int chain = blk >> 2, e = (blk & 3) * 512 + tid, dk = e >> 6, dir = chain >> 3;
    float* kv = (float*)(ws + OFF_KV) + (size_t)chain * 132 * 2048 + e;
    const float* dec = (const float*)(ws + OFF_DEC) + (size_t)chain * 132 * 32 + dk;
    float state = 0.f;
#pragma unroll 1
    for (int s0 = 0; s0 < 132; s0 += 12) {
      float kvv[12], dd[12]; int scs[12];
#pragma unroll
      for (int q = 0; q < 12; ++q) {
        const int s = s0 + q;
        const int sc = dir == 0 ? (s < 4 ? 128 + s : s - 4) : 131 - s;
        scs[q] = sc; kvv[q] = kv[(size_t)sc * 2048]; dd[q] = dec[sc * 32];
      }
#pragma unroll
      for (int q = 0; q < 12; ++q) { if (scs[q] < 128) kv[(size_t)scs[q] * 2048] = state; state = dd[q] * state + kvv[q]; }
    }
  }
}

DI void gla_out_item(const Params& p, unsigned char* lds, int layer, int b, int sc, int h, int tid) {
  unsigned char* ws = p.ws;
  float* lf = (float*)lds;
  float* qf = lf;
  float* qb = qf + 64 * 33;
  float* kf = qb + 64 * 33;
  float* kb = kf + 64 * 33;
  float* gf = kb + 64 * 33;
  float* gb = gf + 64 * 33;
  float* vs = gb + 64 * 33;
  float* S = vs + 64 * 68;
  float* spf = S + 64 * 65;
  float* spb = spf + 32 * 68;
  const int row0 = gla_row(b, sc, 0);
  const float* gq = (const float*)(ws + OFF_GQ) + (size_t)row0 * 128 + h * 32;
  const float* gk = (const float*)(ws + OFF_GK) + (size_t)row0 * 128 + h * 32;
  const float* gv = (const float*)(ws + OFF_GV) + (size_t)row0 * 256 + h * 64;
  const float* lr = (const float*)(ws + OFF_LR) + (size_t)row0 * 32;
  const float* pf = (const float*)(ws + OFF_KV) + (((size_t)(0 * 2 + b) * 4 + h) * 132 + sc) * 2048;
  const float* pb = (const float*)(ws + OFF_KV) + (((size_t)(1 * 2 + b) * 4 + h) * 132 + sc) * 2048;
  f32x4 eg0, eg1;
  {
    const int ei = tid >> 3, edv0 = (tid & 7) * 8;
    const float* g = p.out_norm_g + layer * 1024 + 768 + h * 64 + edv0;
    const float* gr = (const float*)(ws + OFF_GR) + (size_t)(row0 + ei) * 256 + h * 64 + edv0;
    const f32x4 g0 = *(const f32x4*)g, g1 = *(const f32x4*)(g + 4), r0 = *(const f32x4*)gr, r1 = *(const f32x4*)(gr + 4);
    eg0 = (f32x4){g0.x * siluf(r0.x), g0.y * siluf(r0.y), g0.z * siluf(r0.z), g0.w * siluf(r0.w)};
    eg1 = (f32x4){g1.x * siluf(r1.x), g1.y * siluf(r1.y), g1.z * siluf(r1.z), g1.w * siluf(r1.w)};
  }
  __syncthreads();
  for (int e = tid; e < 2048; e += NT) {
    const int i = e >> 5, d = e & 31; const float q = gq[i * 128 + d], k = gk[i * 128 + d];
    const float zf = ((const float*)(ws + OFF_LGF))[(size_t)(row0 + i) * 128 + h * 32 + d], zb = ((const float*)(ws + OFF_LGB))[(size_t)(row0 + i) * 128 + h * 32 + d];
    qf[i * 33 + d] = q; qb[i * 33 + d] = q; kf[i * 33 + d] = k; kb[i * 33 + d] = k; gf[i * 33 + d] = zf; gb[i * 33 + d] = zb;
    if (sc < 128) { spf[(e >> 6) * 68 + (e & 63)] = pf[e]; spb[(e >> 6) * 68 + (e & 63)] = pb[e]; }
    else {
      const float* kvf = (const float*)(ws + OFF_KV) + (((size_t)(0 * 2 + b) * 4 + h) * 132) * 2048 + e;
      const float* kvb = (const float*)(ws + OFF_KV) + (((size_t)(1 * 2 + b) * 4 + h) * 132) * 2048 + e;
      const float* dcf = (const float*)(ws + OFF_DEC) + (((size_t)(0 * 2 + b) * 4 + h) * 132) * 32 + (e >> 6);
      const float* dcb = (const float*)(ws + OFF_DEC) + (((size_t)(1 * 2 + b) * 4 + h) * 132) * 32 + (e >> 6);
      float sf = 0.f, sb = 0.f;
      for (int c = 128; c < sc; ++c) sf = dcf[c * 32] * sf + kvf[(size_t)c * 2048];
      for (int c = 131; c > sc; --c) sb = dcb[c * 32] * sb + kvb[(size_t)c * 2048];
      spf[(e >> 6) * 68 + (e & 63)] = sf; spb[(e >> 6) * 68 + (e & 63)] = sb;
    }
  }
  for (int e = tid; e < 4096; e += NT) { const int i = e >> 6, d = e & 63; vs[i * 68 + d] = gv[i * 256 + d]; }
  __syncthreads();
  {
    const int lane = tid & 63, wave = tid >> 6, dir = wave >> 2;
    float* gsrc = dir ? gb : gf; float* qd = dir ? qb : qf; float* kd = dir ? kb : kf;
#pragma unroll
    for (int dd = 0; dd < 8; ++dd) {
      const int d = (wave & 3) * 8 + dd;
      const float x = gsrc[lane * 33 + d];
      const float pre = wave_scan_incl(x, lane), tot = __shfl(pre, 63);
      const float cum = dir == 0 ? pre : tot - pre + x;
      qd[lane * 33 + d] *= __expf(cum); kd[lane * 33 + d] *= __expf(-cum);
    }
  }
  __syncthreads();
  const int lane_ = tid & 63, wave_ = tid >> 6, fr = lane_ & 15, fq = lane_ >> 4, ti = wave_ >> 1, tj0 = (wave_ & 1) * 2;
  {
#pragma unroll
    for (int t = 0; t < 2; ++t) {
      const int tj = tj0 + t;
      f32x4 aF = (f32x4){0.f, 0.f, 0.f, 0.f}, aB = aF;
      if (tj <= ti) {
#pragma unroll
        for (int ks = 0; ks < 8; ++ks) aF = MFMA4F(qf[(ti * 16 + fr) * 33 + ks * 4 + fq], kf[(tj * 16 + fr) * 33 + ks * 4 + fq], aF);
      }
      if (tj >= ti) {
#pragma unroll
        for (int ks = 0; ks < 8; ++ks) aB = MFMA4F(qb[(ti * 16 + fr) * 33 + ks * 4 + fq], kb[(tj * 16 + fr) * 33 + ks * 4 + fq], aB);
      }
#pragma unroll
      for (int jj = 0; jj < 4; ++jj) {
        const int i = ti * 16 + fq * 4 + jj, j = tj * 16 + fr;
        S[i * 65 + j] = (j <= i ? aF[jj] : 0.f) + (j >= i ? aB[jj] : 0.f);
      }
    }
  }
  __syncthreads();
  {
    f32x4 c0 = (f32x4){0.f, 0.f, 0.f, 0.f}, c1 = c0;
    const float* vb = vs + tj0 * 16 + fr; const float* fb = spf + tj0 * 16 + fr; const float* bb = spb + tj0 * 16 + fr;
#pragma unroll 4
    for (int ks = 0; ks < 16; ++ks) {
      const int k = ks * 4 + fq; const float av = S[(ti * 16 + fr) * 65 + k];
      c0 = MFMA4F(av, vb[k * 68], c0); c1 = MFMA4F(av, vb[k * 68 + 16], c1);
    }
#pragma unroll 4
    for (int ks = 0; ks < 8; ++ks) {
      const int k = ks * 4 + fq; const float a1 = qf[(ti * 16 + fr) * 33 + k], a2 = qb[(ti * 16 + fr) * 33 + k];
      c0 = MFMA4F(a1, fb[k * 68], c0); c1 = MFMA4F(a1, fb[k * 68 + 16], c1);
      c0 = MFMA4F(a2, bb[k * 68], c0); c1 = MFMA4F(a2, bb[k * 68 + 16], c1);
    }
    __syncthreads();
#pragma unroll
    for (int jj = 0; jj < 4; ++jj) { float* sp = S + (ti * 16 + fq * 4 + jj) * 65 + tj0 * 16 + fr; sp[0] = c0[jj]; sp[16] = c1[jj]; }
  }
  __syncthreads();
  {
    const int i = tid >> 3, dv0 = (tid & 7) * 8;
    float acc[8];
#pragma unroll
    for (int e = 0; e < 8; ++e) acc[e] = S[i * 65 + dv0 + e];
    float ss = 0.f;
#pragma unroll
    for (int e = 0; e < 8; ++e) ss += acc[e] * acc[e];
    ss += __shfl_xor(ss, 1); ss += __shfl_xor(ss, 2); ss += __shfl_xor(ss, 4);
    const float rstd = rsqrtf(ss * (1.f / 64.f) + EPS);
    const int row = row0 + i;
    float o[8];
    o[0] = acc[0] * rstd * eg0.x; o[1] = acc[1] * rstd * eg0.y; o[2] = acc[2] * rstd * eg0.z; o[3] = acc[3] * rstd * eg0.w;
    o[4] = acc[4] * rstd * eg1.x; o[5] = acc[5] * rstd * eg1.y; o[6] = acc[6] * rstd * eg1.z; o[7] = acc[7] * rstd * eg1.w;
    u32x4 w; w.x = pk2(o[0], o[1]); w.y = pk2(o[2], o[3]); w.z = pk2(o[4], o[5]); w.w = pk2(o[6], o[7]);
    *(u32x4*)((bf16_t*)(ws + OFF_U) + (size_t)row * 1024 + 768 + h * 64 + dv0) = w;
  }
}

DI void p3_run(const Params& p, unsigned char* lds, int layer, int* cnt, int tid_in, int* s_item_p) {
  const bool deal = gdim() == 256;
  bool first = deal;
  for (;;) {
    int tid = tid_in; asm volatile("" : "+v"(tid));
    __syncthreads();
    if (tid == 0) *s_item_p = first ? -1 : atomicAdd(cnt, 1) + (deal ? 256 : 0);
    __syncthreads();
    int it = *s_item_p;
    int ub = 0, uhd = 0, uqb = 0;
    if (it < 0) {
      const int bi = bidx(), x = bi & 7, w = (x & 1) * 32 + (bi >> 3), kvh = (x >> 1) & 1;
      ub = x >> 2; uhd = kvh * 4 + (w >> 4); uqb = w & 15; it = 0; first = false;
    } else if (it < 256) { ub = it >> 7; uhd = (it & 127) >> 4; uqb = it & 15; }
    if (it >= 1840) break;
    if (layer == 3 && it >= 512 && it < 784) continue;
    if (it < 256) {
      const int b = ub, hd = uhd, q0 = b * 8192 + uqb * 512;
      const float cb = attn_score_bound(p, layer, tid & 63);
      if (cb < 64.f) attn_unit<2, false>(p, lds, layer, b, hd, q0, 0, NKEY, cb, tid);
      else { attn_unit<1, true>(p, lds, layer, b, hd, q0, 0, NKEY, cb, tid); attn_unit<1, true>(p, lds, layer, b, hd, q0 + 256, 0, NKEY, cb, tid); }
    }
    else if (it < 512) { const int i = it - 256; hyena_lat_item(p, lds, layer, i >> 7, i & 127, tid); }
    else if (it < 528) { const int i = it - 512, b = i >> 3; attn_unit<1, true>(p, lds, layer, b, i & 7, 16384 + b * 256, 8192, 256, attn_score_bound(p, layer, tid & 63), tid); }
    else if (it < 784) { const int i = it - 528; hyena_ctx_item(p, lds, layer, i >> 7, i & 127, tid); }
    else { const int i = it - 784, b = i / 528, r = i % 528; gla_local_item(p, lds, layer, b, r >> 2, r & 3, tid); }
  }
}

__global__ void __launch_bounds__(NT) mk_fwd(Params p_arg) {
  extern __shared__ __attribute__((aligned(16))) unsigned char lds[];
  __shared__ __attribute__((aligned(16))) int s_misc[4];
  int& s_item = s_misc[0];
  cg::grid_group grid = cg::this_grid();
  int tid = threadIdx.x;
  if (tid < 4) s_misc[tid] = 0;
  __syncthreads();
  typedef const __attribute__((address_space(4))) Params* KP;
#if defined(__HIP_DEVICE_COMPILE__)
  const KP kp = (KP)__builtin_amdgcn_kernarg_segment_ptr();
  unsigned char* ws = kp->ws;
#else
  unsigned char* ws = p_arg.ws;
#endif
#define OPQ() asm volatile("" : "+v"(tid))
#ifdef PROF_A
  unsigned long long t_prev = 0; unsigned long long* tacc = (unsigned long long*)(ws + OFF_CNT + 1024);
  if (blockIdx.x == 0 && threadIdx.x == 0) { for (int i = 0; i < 16; ++i) tacc[i] = 0ull; t_prev = wall_clock64(); }
#define STAMP(k) do { if (blockIdx.x == 0 && threadIdx.x == 0) { const unsigned long long t_ = wall_clock64(); tacc[k] += t_ - t_prev; t_prev = t_; } } while (0)
#else
#define STAMP(k) do {} while (0)
#endif
#if defined(__HIP_DEVICE_COMPILE__)
#define LOADP() KP kq_ = kp; asm volatile("" : "+s"(kq_)); Params p; p.x = kq_->x; p.c = kq_->c; p.ctx = kq_->ctx; p.c_ctx = kq_->c_ctx; p.ada_w = kq_->ada_w; p.ada_b = kq_->ada_b; p.norm1_g = kq_->norm1_g; p.w_in = kq_->w_in; p.q_norm_g = kq_->q_norm_g; p.k_norm_g = kq_->k_norm_g; p.hy_conv_w = kq_->hy_conv_w; p.hy_conv_b = kq_->hy_conv_b; p.filt_w1 = kq_->filt_w1; p.filt_b1 = kq_->filt_b1; p.filt_w2 = kq_->filt_w2; p.filt_b2 = kq_->filt_b2; p.filt_w3 = kq_->filt_w3; p.filt_freq = kq_->filt_freq; p.hy_bias = kq_->hy_bias; p.gla_gate_w = kq_->gla_gate_w; p.gla_gate_b = kq_->gla_gate_b; p.out_norm_g = kq_->out_norm_g; p.w_out = kq_->w_out; p.norm2_g = kq_->norm2_g; p.ffn_w1 = kq_->ffn_w1; p.ffn_w3 = kq_->ffn_w3; p.ffn_w2 = kq_->ffn_w2; p.final_norm_g = kq_->final_norm_g; p.out = kq_->out; p.ws = kq_->ws; unsigned char* ws = p.ws; (void)ws;
#else
#define LOADP() Params p = p_arg; unsigned char* ws = p.ws; (void)ws
#endif
  { LOADP(); if (PH & 1) phase0(p, lds, tid); }
  grid.sync(); STAMP(0);
  XcdBarrier xbar = xcd_barrier_post((unsigned*)(ws + OFF_BAR), (volatile XLAS unsigned*)(s_misc + 2));
  for (int layer = 0; layer < 4; ++layer) {
    OPQ();
    { LOADP(); if (PH & 2) spectra_items(p, layer, lds, tid); }
    OPQ();
    { LOADP(); if (PH & 4) ctx_filters(p, layer, tid); }
    OPQ();
    { LOADP(); if (PH & 8) weight_prep(p, layer, lds, tid); }
    OPQ();
    { LOADP(); if (PH & 16) norm_rows(p, layer, 0, tid); }
    xcd_barrier(xbar); STAMP(1);
    OPQ();
    {
      LOADP();
      pg8::Gemm g{(const bf16_t*)(ws + OFF_U), (const bf16_t*)(ws + OFF_WIN), TOK, 2560, 1024}; pg8::StaticOrder S; S.init(TOK, 2560, gdim(), bidx());
      EpiInproj E{ws, p.q_norm_g + layer * 64, p.k_norm_g + layer * 64};
      if (PH & 32) pg8::gemm_phase<EpiInproj, pg8::StaticOrder, true, true>((PG8_LAS unsigned char*)lds, g, S, E, tid);
    }
    xcd_barrier(xbar); STAMP(2);
    OPQ();
    { int nrep = REP3; asm volatile("" : "+s"(nrep));
#pragma unroll 1
      for (int rep = 0; rep < nrep; ++rep) { OPQ(); LOADP(); p3_run(p, lds, layer, (int*)(ws + OFF_CNT) + layer + 8 * rep, tid, &s_item); } }
    xcd_barrier(xbar); STAMP(3);
    OPQ();
    { LOADP(); if (PH & 128) gla_scan(p, tid); }
    OPQ();
    { LOADP(); if (PH & 256) for (int it = bidx(); it < 264; it += gdim()) hyena_norm_item(p, lds, layer, it / 132, it % 132, tid); }
    OPQ();
    { LOADP(); if (layer < 3) for (int j = bidx() - 64; j >= 0 && j < 32; j += gdim()) gla_out_item(p, lds, layer, j >> 4, 128 + ((j >> 2) & 3), j & 3, tid); }
    xcd_barrier(xbar); STAMP(4);
    OPQ();
    { LOADP(); if (PH & 512) for (int it = bidx(); it < 1024; it += gdim()) gla_out_item(p, lds, layer, it >> 9, (it & 511) >> 2, it & 3, tid); }
    xcd_barrier(xbar); STAMP(5);
    OPQ();
    {
      pg8::Gemm g{(const bf16_t*)(ws + OFF_U), (const bf16_t*)(ws + OFF_WOUT), 16384, 1024, 1024}; pg8::StaticOrder S; S.init(16384, 1024, gdim(), bidx());
      EpiResid E{(float*)(ws + OFF_HRES), (const float*)(ws + OFF_MOD) + layer * 3 * 6144, 2048};
      if (PH & 1024) pg8::gemm_phase<EpiResid, pg8::StaticOrder, true, true>((PG8_LAS unsigned char*)lds, g, S, E, tid);
      OPQ();
      if (PH & 4096) if (layer < 3) { LOADP(); gemm_ctx(p, lds, (const bf16_t*)(ws + OFF_U), (const bf16_t*)(ws + OFF_WOUT), 1024, tid); }
    }
    xcd_barrier(xbar); STAMP(6);
    OPQ();
    { LOADP(); if (PH & 16) norm_rows(p, layer, 1, tid); }
    xcd_barrier(xbar); STAMP(7);
    OPQ();
    {
      const int Mr = layer < 3 ? TOK : 16384;
      pg8::Gemm g{(const bf16_t*)(ws + OFF_U), (const bf16_t*)(ws + OFF_W13), Mr, 5632, 1024}; pg8::StaticOrder S; S.init(Mr, 5632, gdim(), bidx());
      EpiSwiglu E{(bf16_t*)(ws + OFF_HMID)};
      if (PH & 2048) pg8::gemm_phase<EpiSwiglu, pg8::StaticOrder, true, true>((PG8_LAS unsigned char*)lds, g, S, E, tid);
    }
    xcd_barrier(xbar); STAMP(8);
    OPQ();
    {
      pg8::Gemm g{(const bf16_t*)(ws + OFF_HMID), (const bf16_t*)(ws + OFF_W2), 16384, 1024, 2816}; pg8::StaticOrder S; S.init(16384, 1024, gdim(), bidx());
      EpiResid E{(float*)(ws + OFF_HRES), (const float*)(ws + OFF_MOD) + layer * 3 * 6144, 5120};
      if (PH & 8192) pg8::gemm_phase<EpiResid, pg8::StaticOrder, true, true>((PG8_LAS unsigned char*)lds, g, S, E, tid);
      OPQ();
      if (PH & 4096) if (layer < 3) { LOADP(); gemm_ctx(p, lds, (const bf16_t*)(ws + OFF_HMID), (const bf16_t*)(ws + OFF_W2), 2816, tid); }
    }
    xcd_barrier(xbar); STAMP(9);
  }
  OPQ();
  {
    LOADP();
    const int lane = tid & 63, gw = bidx() * 8 + (tid >> 6), nw = gdim() * 8;
    const float* hres = (const float*)(ws + OFF_HRES);
    for (int row = gw; row < 16384; row += nw) {
      const f32x4* xr = (const f32x4*)(hres + (size_t)row * 1024) + lane;
      f32x4 v[4]; float s = 0.f;
#pragma unroll
      for (int j = 0; j < 4; ++j) { v[j] = xr[64 * j]; s += v[j].x * v[j].x + v[j].y * v[j].y + v[j].z * v[j].z + v[j].w * v[j].w; }
      const float rstd = rsqrtf(wave_sum(s) * (1.f / 1024.f) + EPS);
#pragma unroll
      for (int j = 0; j < 4; ++j) {
        const int col = lane * 4 + 256 * j;
        *(f32x4*)(p.out + (size_t)row * 1024 + col) = v[j] * rstd * *(const f32x4*)(p.final_norm_g + col);
      }
    }
  }
#ifdef PROF_A
  if (blockIdx.x == 0 && threadIdx.x == 0) {
    const unsigned long long want = tacc[PROF_A], t0 = wall_clock64();
    while (wall_clock64() - t0 < want) __builtin_amdgcn_s_sleep(8);
  }
#endif
}

extern "C" void kernel_launch(void* const* d_in, const int* in_sizes, int n_in, void* d_out, int out_size, void* d_ws, size_t ws_size, hipStream_t stream) {
  static int grid_blocks = 0;
  if (!grid_blocks) {
    int dev = 0, cus = 0, per_cu = 0;
    hipGetDevice(&dev);
    hipDeviceGetAttribute(&cus, hipDeviceAttributeMultiprocessorCount, dev);
    hipFuncSetAttribute((const void*)mk_fwd, hipFuncAttributeMaxDynamicSharedMemorySize, LDS_BYTES);
    hipOccupancyMaxActiveBlocksPerMultiprocessor(&per_cu, (const void*)mk_fwd, NT, LDS_BYTES);
    if (per_cu < 1) per_cu = 1;
    grid_blocks = cus * per_cu;
    if (ws_size < WS_NEED || n_in != 28) { fprintf(stderr, "kernel_launch: ws_size %zu < %llu or n_in %d != 28\n", ws_size, (unsigned long long)WS_NEED, n_in); grid_blocks = -1; }
  }
  if (grid_blocks < 0) return;
  Params p{};
  const float** pp = (const float**)&p;
  for (int i = 0; i < 28; ++i) pp[i] = (const float*)d_in[i];
  p.out = (float*)d_out; p.ws = (unsigned char*)d_ws;
  void* args[] = {&p};
  hipError_t e = hipLaunchCooperativeKernel((const void*)mk_fwd, dim3(grid_blocks), dim3(NT), args, LDS_BYTES, stream);
  if (e != hipSuccess) fprintf(stderr, "cooperative launch failed: %s (grid %d)\n", hipGetErrorString(e), grid_blocks);
}
```

```cpp
#include <hip/hip_runtime.h>
#include <hip/hip_cooperative_groups.h>
#include <cstdio>
namespace cg = cooperative_groups;

typedef unsigned short bf16_t;
typedef short bf16x8 __attribute__((ext_vector_type(8)));
typedef short s16x4 __attribute__((ext_vector_type(4)));
typedef float f32x4 __attribute__((ext_vector_type(4)));
typedef float f32x16 __attribute__((ext_vector_type(16)));
typedef unsigned u32x4 __attribute__((ext_vector_type(4)));
typedef unsigned u32x2 __attribute__((ext_vector_type(2)));

#define NT 512
#ifndef PH
#define PH 0xffff
#endif
#ifndef REP3
#define REP3 1
#endif
#ifndef REPG
#define REPG 1
#endif
#define LDS_BYTES 143360
#define TOK 16896
#define DM 1024
#define NKEY 8448
#define FFH 2816
#define EPS 1e-6f

#define OFF_CNT 0ULL
#define OFF_MOD 4096ULL
#define OFF_ROPE 299008ULL
#define OFF_H2L 2396160ULL
#define OFF_H2C 10784768ULL
#define OFF_HC 11046912ULL
#define OFF_HRES 12095488ULL
#define OFF_U 81301504ULL
#define OFF_Q 115904512ULL
#define OFF_K 133206016ULL
#define OFF_VT 137531392ULL
#define OFF_WIN 141856768ULL
#define OFF_WOUT 147099648ULL
#define OFF_W13 149196800ULL
#define OFF_W2 160731136ULL
#define OFF_SPEC 166498304ULL
#define OFF_HYP 200056832ULL
#define OFF_GQ 226009088ULL
#define OFF_GK 234659840ULL
#define OFF_GV 243310592ULL
#define OFF_GR 260612096ULL
#define OFF_LR 277913600ULL
#define OFF_LGB 286564352ULL
#define OFF_HYRAW 295215104ULL
#define OFF_KV 312516608ULL
#define OFF_DEC 329818112ULL
#define OFF_HMID 200056832ULL
#define OFF_PART 330088448ULL
#define OFF_BAR 353157120ULL
#define OFF_LGF 353173504ULL
#define WS_NEED 361824256ULL

struct Params {
  const float *x, *c, *ctx, *c_ctx, *ada_w, *ada_b, *norm1_g, *w_in, *q_norm_g, *k_norm_g, *hy_conv_w, *hy_conv_b,
      *filt_w1, *filt_b1, *filt_w2, *filt_b2, *filt_w3, *filt_freq, *hy_bias, *gla_gate_w, *gla_gate_b, *out_norm_g,
      *w_out, *norm2_g, *ffn_w1, *ffn_w3, *ffn_w2, *final_norm_g;
  float* out;
  unsigned char* ws;
};

#define DI __device__ __forceinline__
typedef __bf16 bf2_t __attribute__((ext_vector_type(2)));
typedef float f2_t __attribute__((ext_vector_type(2)));
DI unsigned pk2(float a, float b) { const f2_t v = {a, b}; return __builtin_bit_cast(unsigned, __builtin_convertvector(v, bf2_t)); }
DI bf16_t f2bf(float x) { return (bf16_t)(pk2(x, 0.f) & 0xffffu); }
DI float bf2f(bf16_t v) { return __uint_as_float(((unsigned)v) << 16); }
DI float wave_sum(float v) {
#pragma unroll
  for (int o = 1; o < 64; o <<= 1) v += __shfl_xor(v, o);
  return v;
}
DI float siluf(float x) { return x / (1.f + __expf(-x)); }
DI int bidx() { int b = blockIdx.x; asm volatile("" : "+s"(b)); return b; }
DI int gdim() { int g = gridDim.x; asm volatile("" : "+s"(g)); return g; }
DI int row_mod(int row) { return row < 8192 ? 0 : (row < 16384 ? 1 : 2); }

#define XB_TMO      128
#define XB_XCNT(j)  (256  + 64 * (j))
#define XB_XSUB(j)  (1280 + 64 * (j))
#define XB_XGEN(j)  (2304 + 64 * (j))
#define XB_TOP      3328
#define XB_TOPGEN   3392
#define XCD_BAR_WORDS 3456
#define XB_SPIN_CAP (1u << 18)
#define XLAS __attribute__((address_space(3)))

__device__ __forceinline__ unsigned xb_ld(unsigned* p)              { return __hip_atomic_load(p, __ATOMIC_RELAXED, __HIP_MEMORY_SCOPE_AGENT); }
__device__ __forceinline__ unsigned xb_add(unsigned* p, unsigned v) { return __hip_atomic_fetch_add(p, v, __ATOMIC_RELAXED, __HIP_MEMORY_SCOPE_AGENT); }
__device__ __forceinline__ unsigned xb_xcc_id() { return (unsigned)__builtin_amdgcn_s_getreg((3 << 11) | 20) & 0xFu; }
#define XB_SPIN(cond, bar) do { unsigned _sp = 0; while (cond) { __builtin_amdgcn_s_sleep(1); \
    if ((++_sp & 255u) == 0u) { if (xb_ld(&(bar)[XB_TMO])) break; if (_sp > XB_SPIN_CAP) { atomicAdd(&(bar)[XB_TMO], 1u); break; } } } } while (0)

struct XcdBarrier {
    unsigned* bar; unsigned x;
    volatile XLAS unsigned* st;
};

__device__ __forceinline__ XcdBarrier xcd_barrier_post(unsigned* bar, volatile XLAS unsigned* st) {
    XcdBarrier b; b.bar = bar; b.x = xb_xcc_id(); b.st = st;
    if (threadIdx.x == 0) (void)xb_add(&bar[XB_XCNT(b.x)], 1u);
    return b;
}
__device__ __forceinline__ void xcd_barrier_complete(unsigned* bar, unsigned x, unsigned& nloc, unsigned& nx) {
    const unsigned G = gridDim.x;
    unsigned sum, cnt, mine, sp = 0u;
    for (;;) {
        sum = 0u; cnt = 0u; mine = 0u;
#pragma unroll
        for (unsigned j = 0; j < 16; ++j) { const unsigned c = xb_ld(&bar[XB_XCNT(j)]); sum += c; cnt += (c > 0u) ? 1u : 0u; mine = (j == x) ? c : mine; }
        if (sum == G) break;
        __builtin_amdgcn_s_sleep(1);
        if ((++sp & 255u) == 0u) { if (xb_ld(&bar[XB_TMO])) break; if (sp > XB_SPIN_CAP) { atomicAdd(&bar[XB_TMO], 1u); break; } }
    }
    nloc = mine > 0u ? mine : 1u; nx = cnt > 0u ? cnt : 1u;
}

__device__ __forceinline__ void xcd_barrier(const XcdBarrier& b) {
    asm volatile("s_waitcnt vmcnt(0)" ::: "memory");
    __syncthreads();
    if (threadIdx.x == 0) {
        unsigned* bar = b.bar;
        __builtin_amdgcn_s_waitcnt(0);
        unsigned nloc = b.st[0], nx = b.st[1];
        if (nloc == 0u) { xcd_barrier_complete(bar, b.x, nloc, nx); b.st[0] = nloc; b.st[1] = nx; }
        const unsigned old = xb_add(&bar[XB_XSUB(b.x)], 1u);
        const unsigned gen = old / nloc;
        if (old + 1u == (gen + 1u) * nloc) {
            __builtin_amdgcn_fence(__ATOMIC_RELEASE, "agent");
            asm volatile("s_waitcnt vmcnt(0)" ::: "memory");
            const unsigned og = xb_add(&bar[XB_TOP], 1u);
            const unsigned tg = og / nx;
            if (og + 1u == (tg + 1u) * nx) xb_add(&bar[XB_TOPGEN], 1u);
            else XB_SPIN(xb_ld(&bar[XB_TOPGEN]) == tg, bar);
            __builtin_amdgcn_fence(__ATOMIC_ACQUIRE, "agent");
            xb_add(&bar[XB_XGEN(b.x)], 1u);
            asm volatile("s_waitcnt vmcnt(0)" ::: "memory");
        } else {
            XB_SPIN(xb_ld(&bar[XB_XGEN(b.x)]) == gen, bar);
            __builtin_amdgcn_fence(__ATOMIC_ACQUIRE, "agent");
            asm volatile("s_waitcnt vmcnt(0)" ::: "memory");
        }
    }
    __syncthreads();
}


DI void fft_fwd(float2* buf, int tid) {
#pragma unroll 1
  for (int m = 4096; m >= 1; m >>= 2) {
    const float inv4m = 0.25f / (float)m;
#pragma unroll 2
    for (int i = tid; i < 4096; i += NT) {
      const int j = i & (m - 1), i0 = ((i - j) << 2) + j;
      const float2 x0 = buf[i0], x1 = buf[i0 + m], x2 = buf[i0 + 2 * m], x3 = buf[i0 + 3 * m];
      const float f = (float)j * inv4m;
      const float c1 = __builtin_amdgcn_cosf(f), s1 = -__builtin_amdgcn_sinf(f);
      const float c2 = c1 * c1 - s1 * s1, s2 = 2.f * c1 * s1;
      const float a0r = x0.x + x2.x, a0i = x0.y + x2.y, d0r = x0.x - x2.x, d0i = x0.y - x2.y;
      const float a1r = x1.x + x3.x, a1i = x1.y + x3.y, d1r = x1.x - x3.x, d1i = x1.y - x3.y;
      const float a2r = d0r * c1 - d0i * s1, a2i = d0r * s1 + d0i * c1;
      const float e1r = d1i, e1i = -d1r;
      const float a3r = e1r * c1 - e1i * s1, a3i = e1r * s1 + e1i * c1;
      const float b0r = a0r - a1r, b0i = a0i - a1i, b1r = a2r - a3r, b1i = a2i - a3i;
      buf[i0] = make_float2(a0r + a1r, a0i + a1i);
      buf[i0 + m] = make_float2(b0r * c2 - b0i * s2, b0r * s2 + b0i * c2);
      buf[i0 + 2 * m] = make_float2(a2r + a3r, a2i + a3i);
      buf[i0 + 3 * m] = make_float2(b1r * c2 - b1i * s2, b1r * s2 + b1i * c2);
    }
    __syncthreads();
  }
}
DI void fft_inv(float2* buf, int tid) {
#pragma unroll 1
  for (int m = 1; m < 16384; m <<= 2) {
    const float inv4m = 0.25f / (float)m;
#pragma unroll 2
    for (int i = tid; i < 4096; i += NT) {
      const int j = i & (m - 1), i0 = ((i - j) << 2) + j;
      const float2 x0 = buf[i0], x1 = buf[i0 + m], x2 = buf[i0 + 2 * m], x3 = buf[i0 + 3 * m];
      const float f = (float)j * inv4m;
      const float c1 = __builtin_amdgcn_cosf(f), s1 = __builtin_amdgcn_sinf(f);
      const float c2 = c1 * c1 - s1 * s1, s2 = 2.f * c1 * s1;
      const float tr = x1.x * c2 - x1.y * s2, ti = x1.x * s2 + x1.y * c2;
      const float ur = x3.x * c2 - x3.y * s2, ui = x3.x * s2 + x3.y * c2;
      const float a0r = x0.x + tr, a0i = x0.y + ti, a1r = x0.x - tr, a1i = x0.y - ti;
      const float a2r = x2.x + ur, a2i = x2.y + ui, a3r = x2.x - ur, a3i = x2.y - ui;
      const float vr = a2r * c1 - a2i * s1, vi = a2r * s1 + a2i * c1;
      const float qr = a3r * c1 - a3i * s1, qi = a3r * s1 + a3i * c1;
      const float zr = -qi, zi = qr;
      buf[i0] = make_float2(a0r + vr, a0i + vi);
      buf[i0 + 2 * m] = make_float2(a0r - vr, a0i - vi);
      buf[i0 + m] = make_float2(a1r + zr, a1i + zi);
      buf[i0 + 3 * m] = make_float2(a1r - zr, a1i - zi);
    }
    __syncthreads();
  }
}
DI int brev14(int k) { return (int)(__brev((unsigned)k) >> 18); }

DI void spec_pair(float2* buf, const float4 h, int rk, int rnk) {
  const float2 zk = buf[rk], zn = buf[rnk];
  const float ar = 0.5f * (zk.x + zn.x), ai = 0.5f * (zk.y - zn.y);
  const float tr = zk.x - zn.x, ti = zk.y + zn.y;
  const float br = 0.5f * ti, bi = -0.5f * tr;
  const float pr = ar * h.x - ai * h.y, pi = ar * h.y + ai * h.x;
  const float qr = br * h.z - bi * h.w, qi = br * h.w + bi * h.z;
  buf[rk] = make_float2(pr - qi, pi + qr);
  if (rnk != rk) buf[rnk] = make_float2(pr + qi, -pi + qr);
}
struct SpecRegs { float4 h[16]; float4 hl; };
DI void spec_load(SpecRegs& r, const float4* spec, int tid) {
#pragma unroll
  for (int i = 0; i < 16; ++i) r.h[i] = spec[tid + NT * i];
  r.hl = spec[8192];
}
DI void spec_mul(float2* buf, const SpecRegs& r, int tid) {
#pragma unroll
  for (int i = 0; i < 16; ++i) {
    const int idx = tid + NT * i, rk = 2 * idx, k = brev14(rk), rnk = brev14((16384 - k) & 16383);
    spec_pair(buf, r.h[i], rk, rnk);
  }
  if (tid == 0) spec_pair(buf, r.hl, 1, 1);
  __syncthreads();
}

DI void phase0(const Params& p, unsigned char* lds, int tid) {
  unsigned char* ws = p.ws;
  const int G = gdim(), bid = bidx();
  if (bid == 0 && tid < 64) ((int*)(ws + OFF_CNT))[tid] = 0;
  if (bid == 0) for (int i = tid; i < XCD_BAR_WORDS; i += NT) ((unsigned*)(ws + OFF_BAR))[i] = 0u;
  {
    float4* h = (float4*)(ws + OFF_HRES);
    const float4* x = (const float4*)p.x; const float4* cx = (const float4*)p.ctx;
    const int nlat = 16384 * 256, nall = TOK * 256;
    for (int i = bid * NT + tid; i < nall; i += G * NT) h[i] = i < nlat ? x[i] : cx[i - nlat];
  }
  {
    float2* rt = (float2*)(ws + OFF_ROPE);
    for (int i = bid * NT + tid; i < 8192 * 32; i += G * NT) {
      const int pos = i >> 5, f = i & 31;
      const float invf = powf(10000.f, -(float)(f & 15) / 16.f);
      const float ang = (f < 16 ? (float)(pos >> 6) : (float)(pos & 63)) * invf;
      rt[i] = make_float2(cosf(ang), sinf(ang));
    }
  }
  float* lf = (float*)lds;
  for (int it = bid; it < 4 * 96; it += G) {
    const int l = it / 96, c0 = (it % 96) * 64, kg = tid >> 6, col = tid & 63;
    const float* w = p.ada_w + (size_t)l * 1024 * 6144 + c0 + col;
    float a0 = 0.f, a1 = 0.f, a2 = 0.f;
    float* sl = lf + 2048;
    for (int k = tid; k < 1024; k += NT) { sl[k] = siluf(p.c[k]); sl[1024 + k] = siluf(p.c[1024 + k]); sl[2048 + k] = siluf(p.c_ctx[k]); }
    __syncthreads();
#pragma unroll 8
    for (int k = kg * 128; k < kg * 128 + 128; ++k) {
      const float wv = __builtin_nontemporal_load(w + (size_t)k * 6144);
      a0 += sl[k] * wv; a1 += sl[1024 + k] * wv; a2 += sl[2048 + k] * wv;
    }
    lf[(kg * 3 + 0) * 64 + col] = a0; lf[(kg * 3 + 1) * 64 + col] = a1; lf[(kg * 3 + 2) * 64 + col] = a2;
    __syncthreads();
    if (tid < 192) {
      const int v = tid >> 6;
      float s = p.ada_b[l * 6144 + c0 + col];
      for (int g = 0; g < 8; ++g) s += lf[(g * 3 + v) * 64 + col];
      ((float*)(ws + OFF_MOD))[(l * 3 + v) * 6144 + c0 + col] = s;
    }
    __syncthreads();
  }
  for (int it = bid; it < 4 * (1024 + 32); it += G) {
    const int l = it / 1056, r = it % 1056, isctx = r >= 1024, n = isctx ? 256 : 8192, tile = isctx ? r - 1024 : r;
    const int ps = tid >> 6, j = tid & 63, pos = tile * 8 + ps;
    float* z = lf; float* h1 = lf + 8 * 33;
    if (j < 33) {
      float val;
      if (j == 0) val = (float)pos / (float)(n - 1);
      else {
        const int kb = (j - 1) & 15;
        const float band = 1e-4f + (float)kb * ((15.f - 1e-4f) / 15.f);
        const float omega = (float)(6.283185307179586 / (double)n) * (float)pos;
        const float ph = omega * band;
        val = (j <= 16) ? cosf(ph) : -sinf(ph);
      }
      z[ps * 33 + j] = val;
    }
    __syncthreads();
    const float fr = p.filt_freq[l * 64 + j];
    float a = p.filt_b1[l * 64 + j];
    for (int e = 0; e < 33; ++e) a += z[ps * 33 + e] * p.filt_w1[(l * 33 + e) * 64 + j];
    h1[ps * 64 + j] = sinf(fr * a);
    __syncthreads();
    float a2 = p.filt_b2[l * 64 + j];
    for (int i = 0; i < 64; ++i) a2 += h1[ps * 64 + i] * p.filt_w2[(l * 64 + i) * 64 + j];
    const float h2 = sinf(fr * a2);
    if (isctx) ((float*)(ws + OFF_H2C))[((size_t)l * 256 + pos) * 64 + j] = h2;
    else ((bf16_t*)(ws + OFF_H2L))[((size_t)l * 8192 + pos) * 64 + j] = f2bf(h2);
    __syncthreads();
  }
}

DI float hy_delta(int c) {
  const float mn = -3.0701134573253944f, mx = -15.350567286626972f;
  return fabsf(mn + (float)c * ((mx - mn) / 255.f));
}

DI void norm_row_load(unsigned char* ws, int row, int nsplit, int glayer, int goff, int lane, f32x4 (&v)[4]) {
  const f32x4* xr = (const f32x4*)((const float*)(ws + OFF_HRES) + (size_t)row * 1024) + lane;
#pragma unroll
  for (int j = 0; j < 4; ++j) v[j] = xr[64 * j];
  if (row >= 16384 && nsplit > 0) {
    const float* pr = (const float*)(ws + OFF_PART) + (size_t)(row - 16384) * 1024 + lane * 4;
    const float* gate = (const float*)(ws + OFF_MOD) + (glayer * 3 + 2) * 6144 + goff + lane * 4;
#pragma unroll
    for (int j = 0; j < 4; ++j) {
      f32x4 a = (f32x4){0.f, 0.f, 0.f, 0.f};
      for (int sp = 0; sp < nsplit; ++sp) a += *(const f32x4*)(pr + (size_t)sp * 512 * 1024 + 256 * j);
      v[j] += *(const f32x4*)(gate + 256 * j) * a;
      *(f32x4*)((float*)(ws + OFF_HRES) + (size_t)row * 1024 + lane * 4 + 256 * j) = v[j];
    }
  }
}
DI void norm_row_store(unsigned char* ws, int row, const float* g, const float* mod, int lane, const f32x4 (&v)[4]) {
  float s = 0.f;
#pragma unroll
  for (int j = 0; j < 4; ++j) s += v[j].x * v[j].x + v[j].y * v[j].y + v[j].z * v[j].z + v[j].w * v[j].w;
  const float rstd = rsqrtf(wave_sum(s) * (1.f / 1024.f) + EPS);
  bf16_t* u = (bf16_t*)(ws + OFF_U);
#pragma unroll
  for (int j = 0; j < 4; ++j) {
    const int col = lane * 4 + 256 * j;
    const f32x4 gg = *(const f32x4*)(g + col), sh = *(const f32x4*)(mod + col), sc = *(const f32x4*)(mod + 1024 + col);
    const f32x4 o = (v[j] * rstd * gg) * (sc + 1.f) + sh;
    u32x2 w; w.x = pk2(o.x, o.y); w.y = pk2(o.z, o.w);
    *(u32x2*)(u + (size_t)row * 1024 + col) = w;
  }
}
DI void norm_rows(const Params& p, int layer, int which  , int tid) {
  unsigned char* ws = p.ws;
  const int nsplit = which ? (layer < 3 ? 4 : 0) : (layer > 0 ? 11 : 0), glayer = which ? layer : layer - 1, goff = which ? 2048 : 5120;
  const int lane = tid & 63, gw = bidx() * 8 + (tid >> 6), nw = gdim() * 8;
  const float* g = (which ? p.norm2_g : p.norm1_g) + layer * 1024;
  const float* modl = (const float*)(ws + OFF_MOD) + layer * 3 * 6144 + which * 3072;
  for (int row = gw; row < TOK; row += 2 * nw) {
    const int row1 = row + nw; const bool has1 = row1 < TOK;
    f32x4 va[4], vb[4];
    norm_row_load(ws, row, nsplit, glayer, goff, lane, va);
    if (has1) norm_row_load(ws, row1, nsplit, glayer, goff, lane, vb);
    norm_row_store(ws, row, g, modl + row_mod(row) * 6144, lane, va);
    if (has1) norm_row_store(ws, row1, g, modl + row_mod(row1) * 6144, lane, vb);
  }
}

DI void wt_item(const float* W, const float* W2, int K, int N, bf16_t* WT, int mode, int kt, int nt, float* tile, int lane) {
  const int k0 = kt * 32, r0 = nt * 64;
  {
    const int r = r0 + lane;
    const float* src = W; int col = r;
    if (mode == 1) { col = (r >> 5) * 16 + (r & 15); if ((r >> 4) & 1) src = W2; }
    else if (mode == 3) {
      if (r < 2304) col = (r & ~255) + 64 * ((r >> 5) & 3) + 32 * ((r >> 4) & 1) + 16 * ((r >> 7) & 1) + (r & 15);
      else if (r >= 2336) col = -1;
    }
    const float* sp = src + (size_t)k0 * N + (col >= 0 ? col : 0);
    float v[32];
#pragma unroll
    for (int i = 0; i < 32; ++i) v[i] = __builtin_nontemporal_load(sp + (size_t)i * N);
#pragma unroll
    for (int i = 0; i < 32; ++i) tile[i * 65 + lane] = col >= 0 ? v[i] : 0.f;
  }
#pragma unroll
  for (int i = 0; i < 4; ++i) {
    const int c = lane + 64 * i, n = c >> 2, kc = c & 3;
    const float* sp = tile + (kc * 8) * 65 + n;
    u32x4 o; o.x = pk2(sp[0], sp[65]); o.y = pk2(sp[2 * 65], sp[3 * 65]); o.z = pk2(sp[4 * 65], sp[5 * 65]); o.w = pk2(sp[6 * 65], sp[7 * 65]);
    *(u32x4*)(WT + (size_t)(r0 + n) * K + k0 + kc * 8) = o;
  }
}

DI void weight_prep(const Params& p, int layer, unsigned char* lds, int tid) {
  unsigned char* ws = p.ws;
  const int lane = tid & 63, wave = tid >> 6;
  float* tile = (float*)lds + wave * (32 * 65);
  const int I0 = 32 * 40, I1 = 32 * 16, I2 = 32 * 88, I3 = 88 * 16;
  for (int it = bidx() * 8 + wave; it < I0 + I1 + I2 + I3; it += gdim() * 8) {
    int r = it;
    if (r < I0) { wt_item(p.w_in + (size_t)layer * 1024 * 2336, nullptr, 1024, 2336, (bf16_t*)(ws + OFF_WIN), 3, r / 40, r % 40, tile, lane); continue; } r -= I0;
    if (r < I1) { wt_item(p.w_out + (size_t)layer * 1024 * 1024, nullptr, 1024, 1024, (bf16_t*)(ws + OFF_WOUT), 0, r / 16, r % 16, tile, lane); continue; } r -= I1;
    if (r < I2) { wt_item(p.ffn_w1 + (size_t)layer * 1024 * 2816, p.ffn_w3 + (size_t)layer * 1024 * 2816, 1024, 2816, (bf16_t*)(ws + OFF_W13), 1, r / 88, r % 88, tile, lane); continue; } r -= I2;
    wt_item(p.ffn_w2 + (size_t)layer * 2816 * 1024, nullptr, 2816, 1024, (bf16_t*)(ws + OFF_W2), 0, r / 16, r % 16, tile, lane);
  }
  __syncthreads();
}

DI void ctx_filters(const Params& p, int layer, int tid) {
  unsigned char* ws = p.ws;
  const float* h2c = (const float*)(ws + OFF_H2C) + (size_t)layer * 256 * 64;
  float* hc = (float*)(ws + OFF_HC);
  for (int t = bidx(); t < 256; t += gdim()) {
    const float tn = (float)t / 255.f;
#pragma unroll
    for (int cc = 0; cc < 2; ++cc) {
      const int col = tid + cc * 512;
      float a = 0.f;
      for (int j = 0; j < 64; ++j) a += h2c[t * 64 + j] * p.filt_w3[((size_t)layer * 64 + j) * 1024 + col];
      hc[t * 1024 + col] = a * __expf(-tn * hy_delta(col & 255));
    }
  }
}

DI void spectra_items(const Params& p, int layer, unsigned char* lds, int tid) {
  unsigned char* ws = p.ws;
  float2* buf = (float2*)lds;
  float* w3s = (float*)(lds + 131072);
  const bf16_t* h2l = (const bf16_t*)(ws + OFF_H2L) + (size_t)layer * 8192 * 64;
  for (int it = bidx(); it < 256; it += gdim()) {
    const int o = it >> 7, pr = it & 127, ca = 2 * pr;
    if (tid < 256) {
      const int j = tid >> 2, q = tid & 3, sign = q >> 1, ch = ca + (q & 1);
      w3s[tid] = p.filt_w3[((size_t)layer * 64 + j) * 1024 + o * 512 + sign * 256 + ch];
    }
    __syncthreads();
    const float da = hy_delta(ca), db = hy_delta(ca + 1);
#pragma unroll 1
    for (int t = tid; t < 8192; t += NT) {
      const u32x4* hr = (const u32x4*)(h2l + (size_t)t * 64);
      float a0 = 0.f, a1 = 0.f, a2 = 0.f, a3 = 0.f;
#pragma unroll 4
      for (int jj = 0; jj < 8; ++jj) {
        const u32x4 hq = hr[jj];
#pragma unroll
        for (int e = 0; e < 4; ++e) {
          const float lo = __uint_as_float(hq[e] << 16), hi = __uint_as_float(hq[e] & 0xffff0000u);
          const f32x4 wl = *(const f32x4*)(w3s + (jj * 8 + e * 2) * 4), wh = *(const f32x4*)(w3s + (jj * 8 + e * 2 + 1) * 4);
          a0 += lo * wl.x + hi * wh.x; a1 += lo * wl.y + hi * wh.y; a2 += lo * wl.z + hi * wh.z; a3 += lo * wl.w + hi * wh.w;
        }
      }
      const float tn = (float)t / 8191.f, wa = __expf(-tn * da), wb = __expf(-tn * db);
      buf[t] = make_float2(a0 * wa, a1 * wb);
      if (t == 0) buf[8192] = make_float2(0.f, 0.f);
      else buf[16384 - t] = make_float2(a2 * wa, a3 * wb);
    }
    __syncthreads();
    fft_fwd(buf, tid);
    float4* spec = (float4*)(ws + OFF_SPEC) + (size_t)it * 8193;
#pragma unroll 2
    for (int idx = tid; idx <= 8192; idx += NT) {
      const int rk = idx < 8192 ? 2 * idx : 1, k = brev14(rk), rnk = brev14((16384 - k) & 16383);
      const float2 zk = buf[rk], zn = buf[rnk];
      const float tr = zk.x - zn.x, ti = zk.y + zn.y;
      __builtin_nontemporal_store((f32x4){0.5f * (zk.x + zn.x), 0.5f * (zk.y - zn.y), 0.5f * ti, -0.5f * tr}, (f32x4*)(spec + idx));
    }
    __syncthreads();
  }
}

#define MFMA16(a, b, c) __builtin_amdgcn_mfma_f32_16x16x32_bf16((a), (b), (c), 0, 0, 0)
#define MFMA32(a, b, c) __builtin_amdgcn_mfma_f32_32x32x16_bf16((a), (b), (c), 0, 0, 0)
#define MFMA4F(a, b, c) __builtin_amdgcn_mfma_f32_16x16x4f32((a), (b), (c), 0, 0, 0)
#define LSA 72

DI float log_sigmoid(float z) { return fminf(z, 0.f) - log1pf(__expf(-fabsf(z))); }

DI void gemm_ctx(const Params& p, unsigned char* lds, const bf16_t* A, const bf16_t* Bt, int K, int tid) {
  unsigned char* ws = p.ws;
  const int lane = tid & 63, wave = tid >> 6, wm = wave >> 1, wn = wave & 1, fr = lane & 15, fq = lane >> 4;
  const int S = K / 256, njobs = 16 * S;
  bf16_t* As = (bf16_t*)lds;
  bf16_t* Bs = (bf16_t*)(lds + 73728);
  for (int job = bidx(); job < njobs; job += gdim()) {
    const int tile = job % 16, ks = job / 16, tm = 64 + (tile >> 3), tn = tile & 7;
    const bf16_t* Ag = A + (size_t)(tm * 256) * K + ks * 256;
    const bf16_t* Bg = Bt + (size_t)(tn * 128) * K + ks * 256;
    f32x4 acc[4][4];
#pragma unroll
    for (int m = 0; m < 4; ++m)
#pragma unroll
      for (int n = 0; n < 4; ++n) acc[m][n] = (f32x4){0.f, 0.f, 0.f, 0.f};
    u32x4 ra[4], rb[2];
#pragma unroll
    for (int i = 0; i < 4; ++i) { const int c = tid + NT * i; ra[i] = *(const u32x4*)(Ag + (size_t)(c >> 3) * K + (c & 7) * 8); }
#pragma unroll
    for (int i = 0; i < 2; ++i) { const int c = tid + NT * i; rb[i] = *(const u32x4*)(Bg + (size_t)(c >> 3) * K + (c & 7) * 8); }
#pragma unroll
    for (int i = 0; i < 4; ++i) { const int c = tid + NT * i; *(u32x4*)(As + (c >> 3) * LSA + (c & 7) * 8) = ra[i]; }
#pragma unroll
    for (int i = 0; i < 2; ++i) { const int c = tid + NT * i; *(u32x4*)(Bs + (c >> 3) * LSA + (c & 7) * 8) = rb[i]; }
    __syncthreads();
    for (int kt = 0; kt < 4; ++kt) {
      const int cur = kt & 1;
      if (kt + 1 < 4) {
        const int k0 = (kt + 1) * 64;
#pragma unroll
        for (int i = 0; i < 4; ++i) { const int c = tid + NT * i; ra[i] = *(const u32x4*)(Ag + (size_t)(c >> 3) * K + k0 + (c & 7) * 8); }
#pragma unroll
        for (int i = 0; i < 2; ++i) { const int c = tid + NT * i; rb[i] = *(const u32x4*)(Bg + (size_t)(c >> 3) * K + k0 + (c & 7) * 8); }
      }
      const bf16_t* as = As + cur * (256 * LSA) + (wm * 64 + fr) * LSA + fq * 8;
      const bf16_t* bs = Bs + cur * (128 * LSA) + (wn * 64 + fr) * LSA + fq * 8;
#pragma unroll
      for (int ks2 = 0; ks2 < 2; ++ks2) {
        bf16x8 af[4], bfr[4];
#pragma unroll
        for (int m = 0; m < 4; ++m) af[m] = *(const bf16x8*)(as + m * 16 * LSA + ks2 * 32);
#pragma unroll
        for (int n = 0; n < 4; ++n) bfr[n] = *(const bf16x8*)(bs + n * 16 * LSA + ks2 * 32);
#pragma unroll
        for (int m = 0; m < 4; ++m)
#pragma unroll
          for (int n = 0; n < 4; ++n) acc[m][n] = MFMA16(bfr[n], af[m], acc[m][n]);
      }
      if (kt + 1 < 4) {
        const int nb = cur ^ 1;
#pragma unroll
        for (int i = 0; i < 4; ++i) { const int c = tid + NT * i; *(u32x4*)(As + nb * (256 * LSA) + (c >> 3) * LSA + (c & 7) * 8) = ra[i]; }
#pragma unroll
        for (int i = 0; i < 2; ++i) { const int c = tid + NT * i; *(u32x4*)(Bs + nb * (128 * LSA) + (c >> 3) * LSA + (c & 7) * 8) = rb[i]; }
      }
      __syncthreads();
    }
    float* part = (float*)(ws + OFF_PART) + (size_t)ks * 512 * 1024;
    const int prow0 = (tm - 64) * 256 + wm * 64, col0 = tn * 128 + wn * 64;
#pragma unroll
    for (int m = 0; m < 4; ++m)
#pragma unroll
      for (int n = 0; n < 4; ++n) *(f32x4*)(part + (size_t)(prow0 + m * 16 + fr) * 1024 + col0 + n * 16 + fq * 4) = acc[m][n];
  }
}

namespace pg8 {
#define PG8_LAS __attribute__((address_space(3)))
using ::bf16_t; using ::bf16x8; using ::f32x4; using ::u32x4;
constexpr int BM = 256, BK = 64, HALF = 128, HTB = HALF * BK * 2  , STAGE_BYTES = 8 * HTB, NXCD = 8, WGM = 8;

__host__ __device__ __forceinline__ int lds_byte(int r, int c) { const int st = (r >> 4) * 2 + (c >> 5), rr = r & 15, cc = c & 31, ob = rr * 64 + cc * 2; return st * 1024 + (ob ^ (((ob >> 9) & 1) << 5)); }
__host__ __device__ __forceinline__ void stage_rc(int b, int& R, int& C) { const int st = b / 1024, sb = b % 1024, swz = sb ^ (((sb >> 9) & 1) << 5); R = (st >> 1) * 16 + swz / 64; C = (st & 1) * 32 + (swz % 64) / 2; }
__host__ __device__ __forceinline__ int perm32(int rho) { const int n = rho >> 4, i = rho & 15; return 8 * (i >> 2) + 4 * n + (i & 3); }

struct Unit { int pm, pn; };
struct Gemm { const bf16_t* A; const bf16_t* Bt; int M, N, K; };

struct StaticOrder {
    int nM, nN, nwg, G, c;
    __host__ __device__ void init(int M, int N, int G_, int c_) { nM = M / BM; nN = N / BM; nwg = nM * nN; G = G_; c = c_; }
    __host__ __device__ bool next(int i, Unit& u) const {
        const long L = (long)i * G + c; if (L >= nwg) return false;
        int wgid = (int)L; { const int q = nwg / NXCD, r = nwg % NXCD, xcd = wgid % NXCD, off = wgid / NXCD; wgid = (xcd < r ? xcd * (q + 1) : r * (q + 1) + (xcd - r) * q) + off; }
        const int nig = WGM * nN, gid = wgid / nig, fm = gid * WGM, gsz = (nM - fm) < WGM ? (nM - fm) : WGM;
        u.pm = fm + ((wgid % nig) % gsz); u.pn = (wgid % nig) / gsz; return true;
    }
    __device__ __forceinline__ void a_ready(const Unit&) const {}
    __device__ __forceinline__ void done(const Unit&) const {}
};

template <class Epi, class Sched, bool ALIGN_EPI = false, bool SP2 = false>
__device__ __forceinline__ void gemm_phase(PG8_LAS unsigned char* lds, const Gemm g, const Sched& S, const Epi& E, const int tid) {
    const int wid = __builtin_amdgcn_readfirstlane(tid >> 6), lane = tid & 63, wr = wid >> 2, wc = wid & 3, fr = lane & 15, fq = lane >> 4;
    const int K = g.K, nt = K / BK;
    unsigned voffA[2], voffB[2];
#pragma unroll
    for (int i = 0; i < 2; ++i) { int R, C; stage_rc(tid * 16 + i * 8192, R, C); const int Rb = Epi::PERM ? ((R & ~31) + perm32(R & 31)) : R;
        voffA[i] = (unsigned)(R * K + C) * 2u; voffB[i] = (unsigned)(Rb * K + C) * 2u; }
    const size_t kstep = (size_t)(BK * 2);
    const size_t hstep = (size_t)HALF * K * 2;
    const size_t tstep = 2 * hstep;
    const unsigned ldsw = (unsigned)wid * 1024u;
    const int aoff = lds_byte(wr * 64 + fr, fq * 8), boff = lds_byte(wc * 32 + fr, fq * 8);
#define PG8_SA(b, h) (((b) * 2 + (h)) * HTB)
#define PG8_SB(b, h) ((4 + (b) * 2 + (h)) * HTB)
#define PG8_STAGE(bufoff, gbase, voff) do { _Pragma("unroll") for (int _i = 0; _i < 2; ++_i) \
        __builtin_amdgcn_global_load_lds((const unsigned*)((const char*)(gbase) + (voff)[_i]), (PG8_LAS unsigned*)(lds + (bufoff) + ldsw + _i * 8192), 16, 0, 0); } while (0)
#define PG8_LDA(dst, b, h) do { _Pragma("unroll") for (int m = 0; m < 4; ++m) _Pragma("unroll") for (int k = 0; k < 2; ++k) dst[m][k] = *(const PG8_LAS bf16x8*)(lds + PG8_SA(b, h) + aoff + m * 2048 + k * 1024); } while (0)
#define PG8_LDB(dst, b, h) do { _Pragma("unroll") for (int n = 0; n < 2; ++n) _Pragma("unroll") for (int k = 0; k < 2; ++k) dst[n][k] = *(const PG8_LAS bf16x8*)(lds + PG8_SB(b, h) + boff + n * 2048 + k * 1024); } while (0)
#define PG8_MMA(ai, bj, At, Bt) do { __builtin_amdgcn_s_setprio(1); _Pragma("unroll") for (int m = 0; m < 4; ++m) _Pragma("unroll") for (int n = 0; n < 2; ++n) _Pragma("unroll") for (int k = 0; k < 2; ++k) \
        acc[ai][bj][m][n] = __builtin_amdgcn_mfma_f32_16x16x32_bf16(Bt[n][k], At[m][k], acc[ai][bj][m][n], 0, 0, 0); __builtin_amdgcn_s_setprio(0); } while (0)
#define PG8_WAIT_V(n) asm volatile("s_waitcnt vmcnt(" #n ")" ::: "memory")
#define PG8_WAIT_L(n) asm volatile("s_waitcnt lgkmcnt(" #n ")" ::: "memory")
#define PG8_BAR __builtin_amdgcn_s_barrier()
#define PG8_SCHED __builtin_amdgcn_sched_barrier(0)
    Unit cur, nxt; int ui = 0;
    if (!S.next(0, cur)) return;
    f32x4 acc[2][2][4][2];
#pragma unroll
    for (int a = 0; a < 2; ++a)
#pragma unroll
        for (int b = 0; b < 2; ++b)
#pragma unroll
            for (int m = 0; m < 4; ++m)
#pragma unroll
                for (int n = 0; n < 2; ++n) acc[a][b][m][n] = (f32x4){0.f, 0.f, 0.f, 0.f};
    bf16x8 At[4][2], B0[2][2], B1[2][2];
    const char* cA = (const char*)g.A + (size_t)cur.pm * tstep; const char* cB = (const char*)g.Bt + (size_t)cur.pn * tstep;
    S.a_ready(cur);
    if constexpr (SP2) {
        PG8_STAGE(PG8_SB(0, 0), cB, voffB); PG8_STAGE(PG8_SB(0, 1), cB + hstep, voffB); PG8_STAGE(PG8_SA(0, 0), cA, voffA); PG8_STAGE(PG8_SA(0, 1), cA + hstep, voffA);
        if (wr == 1) PG8_BAR;
        PG8_WAIT_V(2); PG8_BAR;
        PG8_STAGE(PG8_SB(1, 0), cB + kstep, voffB); PG8_STAGE(PG8_SA(1, 0), cA + kstep, voffA); PG8_STAGE(PG8_SB(1, 1), cB + hstep + kstep, voffB);
        PG8_WAIT_V(6); PG8_BAR;
    } else {
        PG8_STAGE(PG8_SB(0, 0), cB, voffB); PG8_STAGE(PG8_SA(0, 0), cA, voffA); PG8_STAGE(PG8_SB(0, 1), cB + hstep, voffB); PG8_STAGE(PG8_SA(0, 1), cA + hstep, voffA);
        if (wr == 1) PG8_BAR;
        PG8_WAIT_V(4); PG8_BAR;
        PG8_STAGE(PG8_SB(1, 0), cB + kstep, voffB); PG8_STAGE(PG8_SA(1, 0), cA + kstep, voffA); PG8_STAGE(PG8_SB(1, 1), cB + hstep + kstep, voffB);
        PG8_WAIT_V(6); PG8_BAR;
    }
    for (;;) {
        const bool has_next = S.next(ui + 1, nxt);
        const char* nA = has_next ? (const char*)g.A + (size_t)nxt.pm * tstep : cA; const char* nB = has_next ? (const char*)g.Bt + (size_t)nxt.pn * tstep : cB;
        for (int t = 0; t < nt; t += 2) {
            const bool last = (t == nt - 2);
            const char* a1 = cA + (size_t)(t + 1) * kstep;
            const char* a2 = last ? nA : cA + (size_t)(t + 2) * kstep; const char* b2 = last ? nB : cB + (size_t)(t + 2) * kstep;
            const char* a3 = a2 + kstep; const char* b3 = b2 + kstep;
            if (last && has_next) S.a_ready(nxt);
            if constexpr (SP2) {
            PG8_LDB(B0, 0, 0); PG8_LDB(B1, 0, 1); PG8_SCHED; PG8_LDA(At, 0, 0); PG8_STAGE(PG8_SA(1, 1), a1 + hstep, voffA);
            PG8_WAIT_V(8); PG8_WAIT_L(0); PG8_BAR; PG8_MMA(0, 0, At, B0); PG8_MMA(0, 1, At, B1); PG8_BAR; PG8_SCHED;
            PG8_LDA(At, 0, 1); PG8_STAGE(PG8_SB(0, 0), b2, voffB); PG8_STAGE(PG8_SB(0, 1), b2 + hstep, voffB); PG8_STAGE(PG8_SA(0, 0), a2, voffA);
            PG8_WAIT_V(8); PG8_WAIT_L(0); PG8_BAR; PG8_MMA(1, 0, At, B0); PG8_MMA(1, 1, At, B1); PG8_BAR; PG8_SCHED;
            PG8_LDB(B0, 1, 0); PG8_LDB(B1, 1, 1); PG8_SCHED; PG8_LDA(At, 1, 0); PG8_STAGE(PG8_SA(0, 1), a2 + hstep, voffA);
            PG8_WAIT_V(8); PG8_WAIT_L(0); PG8_BAR; PG8_MMA(0, 0, At, B0); PG8_MMA(0, 1, At, B1); PG8_BAR; PG8_SCHED;
            PG8_LDA(At, 1, 1); PG8_STAGE(PG8_SB(1, 0), b3, voffB); PG8_STAGE(PG8_SB(1, 1), b3 + hstep, voffB); PG8_STAGE(PG8_SA(1, 0), a3, voffA);
            PG8_WAIT_V(8); PG8_WAIT_L(0); PG8_BAR; PG8_MMA(1, 0, At, B0); PG8_MMA(1, 1, At, B1); PG8_BAR; PG8_SCHED;
            } else {
            PG8_LDB(B0, 0, 0); PG8_SCHED; PG8_LDA(At, 0, 0); PG8_STAGE(PG8_SA(1, 1), a1 + hstep, voffA);
            PG8_WAIT_L(8); PG8_BAR; PG8_WAIT_L(0); PG8_MMA(0, 0, At, B0); PG8_BAR; PG8_SCHED;
            PG8_LDB(B1, 0, 1); PG8_STAGE(PG8_SB(0, 0), b2, voffB);
            PG8_BAR; PG8_WAIT_L(0); PG8_MMA(0, 1, At, B1); PG8_BAR;
            PG8_LDA(At, 0, 1); PG8_STAGE(PG8_SA(0, 0), a2, voffA);
            PG8_BAR; PG8_WAIT_L(0); PG8_MMA(1, 0, At, B0); PG8_BAR; PG8_SCHED;
            PG8_STAGE(PG8_SB(0, 1), b2 + hstep, voffB);
            PG8_WAIT_V(6); PG8_BAR; PG8_MMA(1, 1, At, B1); PG8_BAR;
            PG8_LDB(B0, 1, 0); PG8_SCHED; PG8_LDA(At, 1, 0); PG8_STAGE(PG8_SA(0, 1), a2 + hstep, voffA);
            PG8_WAIT_L(8); PG8_BAR; PG8_WAIT_L(0); PG8_MMA(0, 0, At, B0); PG8_BAR; PG8_SCHED;
            PG8_LDB(B1, 1, 1); PG8_STAGE(PG8_SB(1, 0), b3, voffB);
            PG8_BAR; PG8_WAIT_L(0); PG8_MMA(0, 1, At, B1); PG8_BAR;
            PG8_LDA(At, 1, 1); PG8_STAGE(PG8_SA(1, 0), a3, voffA);
            PG8_BAR; PG8_WAIT_L(0); PG8_MMA(1, 0, At, B0); PG8_BAR; PG8_SCHED;
            PG8_STAGE(PG8_SB(1, 1), b3 + hstep, voffB);
            PG8_WAIT_V(6); PG8_BAR; PG8_MMA(1, 1, At, B1); PG8_BAR;
            }
        }
        if constexpr (ALIGN_EPI) { if (wr == 0) PG8_BAR; }
        if constexpr (!Epi::AFTER_DRAIN) { E(acc, cur, wr, wc, fr, fq); S.done(cur); }
        if (!has_next) break;
#pragma unroll
        for (int a = 0; a < 2; ++a)
#pragma unroll
            for (int b = 0; b < 2; ++b)
#pragma unroll
                for (int m = 0; m < 4; ++m)
#pragma unroll
                    for (int n = 0; n < 2; ++n) acc[a][b][m][n] = (f32x4){0.f, 0.f, 0.f, 0.f};
        cur = nxt; cA = nA; cB = nB; ++ui;
        if constexpr (ALIGN_EPI) { if (wr == 1) PG8_BAR; }
    }
    PG8_WAIT_V(0);
    if constexpr (!ALIGN_EPI) { if (wr == 0) PG8_BAR; }
    PG8_BAR;
    if constexpr (Epi::AFTER_DRAIN) { E.fused(acc, cur, wr, wc, fr, fq, lds, wid, lane); S.done(cur); }
#undef PG8_SA
#undef PG8_SB
#undef PG8_STAGE
#undef PG8_LDA
#undef PG8_LDB
#undef PG8_MMA
#undef PG8_WAIT_V
#undef PG8_WAIT_L
#undef PG8_BAR
#undef PG8_SCHED
}
}


struct EpiResid {
  static constexpr bool PERM = false, AFTER_DRAIN = false;
  float* hres; const float* modl; int goff;
  __device__ __forceinline__ void operator()(const f32x4 (&acc)[2][2][4][2], const pg8::Unit& u, int wr, int wc, int fr_, int fq_) const {
    int fr = fr_, fq = fq_; asm volatile("" : "+v"(fr), "+v"(fq));
    const int row0 = u.pm * 256 + wr * 64 + fr, col0 = u.pn * 256 + wc * 32 + 4 * fq;
    const float* gm = modl + (u.pm < 32 ? 0 : (u.pm < 64 ? 1 : 2)) * 6144 + goff;
#pragma unroll
    for (int bj = 0; bj < 2; ++bj)
#pragma unroll
      for (int n = 0; n < 2; ++n) {
        const int col = col0 + bj * 128 + n * 16;
        const f32x4 g = *(const f32x4*)(gm + col);
#pragma unroll
        for (int ai = 0; ai < 2; ++ai)
#pragma unroll
          for (int m = 0; m < 4; ++m) {
            f32x4* hp = (f32x4*)(hres + (size_t)(row0 + ai * 128 + m * 16) * 1024 + col);
            *hp = *hp + g * acc[ai][bj][m][n];
          }
        asm volatile("" ::: "memory");
      }
  }
};
struct EpiSwiglu {
  static constexpr bool PERM = false, AFTER_DRAIN = false;
  bf16_t* hm;
  __device__ __forceinline__ void operator()(const f32x4 (&acc)[2][2][4][2], const pg8::Unit& u, int wr, int wc, int fr_, int fq_) const {
    int fr = fr_, fq = fq_; asm volatile("" : "+v"(fr), "+v"(fq));
    const int row0 = u.pm * 256 + wr * 64 + fr, hid0 = u.pn * 128 + wc * 16 + 4 * fq;
#pragma unroll
    for (int ai = 0; ai < 2; ++ai)
#pragma unroll
      for (int m = 0; m < 4; ++m)
#pragma unroll
        for (int bj = 0; bj < 2; ++bj) {
          const f32x4 a = acc[ai][bj][m][0], g = acc[ai][bj][m][1];
          u32x2 w; w.x = pk2(siluf(a.x) * g.x, siluf(a.y) * g.y); w.y = pk2(siluf(a.z) * g.z, siluf(a.w) * g.w);
          *(u32x2*)(hm + (size_t)(row0 + ai * 128 + m * 16) * FFH + hid0 + bj * 64) = w;
        }
  }
};
struct EpiInproj {
  static constexpr bool PERM = false, AFTER_DRAIN = false;
  unsigned char* ws; const float *qg, *kg;
  __device__ __forceinline__ void operator()(const f32x4 (&acc)[2][2][4][2], const pg8::Unit& u, int wr, int wc, int fr_, int fq_) const {
    int fr = fr_, fq = fq_; asm volatile("" : "+v"(fr), "+v"(fq));
    const int pn = u.pn, pm = u.pm;
    const bool isctx = pm >= 64;
    const int b = isctx ? pm - 64 : pm >> 5;
    const int rowb = pm * 256 + wr * 64 + fr;
#ifndef EB
#define EB 15
#endif
    if ((EB & 1) && (pn < 2 || (pn == 2 && wc < 2))) {
      const bool isq = pn < 2;
      const float* g = isq ? qg : kg;
      const float sc = isq ? 0.125f * 1.4426950408889634f : 1.f;
#pragma unroll
      for (int ai = 0; ai < 2; ++ai)
#pragma unroll
        for (int m = 0; m < 4; ++m) {
          const int row = rowb + ai * 128 + m * 16;
          float ss = 0.f;
#pragma unroll
          for (int bj = 0; bj < 2; ++bj)
#pragma unroll
            for (int n = 0; n < 2; ++n) { const f32x4 x = acc[ai][bj][m][n]; ss += x.x * x.x + x.y * x.y + x.z * x.z + x.w * x.w; }
          ss += __shfl_xor(ss, 16); ss += __shfl_xor(ss, 32);
          const float rstd = rsqrtf(ss * (1.f / 64.f) + EPS);
          const int pos = isctx ? (row & 255) : (row & 8191), tok = isctx ? 8192 + pos : pos;
          bf16_t* dst = isq ? (bf16_t*)(ws + OFF_Q) + (size_t)row * 512 + (pn * 4 + wc) * 64 : (bf16_t*)(ws + OFF_K) + ((size_t)(b * 2 + wc) * NKEY + tok) * 64;
#pragma unroll
          for (int bj = 0; bj < 2; ++bj) {
            const int d0 = 16 * bj + 4 * fq;
            f32x4 x0 = acc[ai][bj][m][0] * rstd * *(const f32x4*)(g + d0), x1 = acc[ai][bj][m][1] * rstd * *(const f32x4*)(g + 32 + d0);
            if (!isctx) {
              const f32x4* rt = (const f32x4*)((const float2*)(ws + OFF_ROPE) + (size_t)pos * 32 + d0);
              const f32x4 cs0 = rt[0], cs1 = rt[1];
              const f32x4 c = (f32x4){cs0.x, cs0.z, cs1.x, cs1.z}, sn = (f32x4){cs0.y, cs0.w, cs1.y, cs1.w};
              const f32x4 y0 = x0 * c - x1 * sn, y1 = x0 * sn + x1 * c;
              x0 = y0; x1 = y1;
            }
            x0 = x0 * sc; x1 = x1 * sc;
            u32x2 w0, w1; w0.x = pk2(x0.x, x0.y); w0.y = pk2(x0.z, x0.w); w1.x = pk2(x1.x, x1.y); w1.y = pk2(x1.z, x1.w);
            *(u32x2*)(dst + d0) = w0; *(u32x2*)(dst + 32 + d0) = w1;
          }
        }
    } else if ((EB & 2) && pn < 6) {
      bf16_t* base = pn == 2 ? (bf16_t*)(ws + OFF_VT) + ((size_t)(b * 2 + (wc - 2)) * 64) * NKEY : (bf16_t*)(ws + OFF_HYP) + ((size_t)b * 768 + (pn - 3) * 256 + wc * 64) * NKEY;
#pragma unroll
      for (int ai = 0; ai < 2; ++ai)
#pragma unroll
        for (int m = 0; m < 4; ++m) {
          const int row = rowb + ai * 128 + m * 16;
          const int tok = isctx ? 8192 + (row & 255) : (row & 8191);
#pragma unroll
          for (int bj = 0; bj < 2; ++bj)
#pragma unroll
            for (int n = 0; n < 2; ++n) {
              const f32x4 x = acc[ai][bj][m][n];
              bf16_t* dp = base + (size_t)(32 * n + 16 * bj + 4 * fq) * NKEY + tok;
              dp[0] = f2bf(x.x); dp[NKEY] = f2bf(x.y); dp[2 * NKEY] = f2bf(x.z); dp[3 * NKEY] = f2bf(x.w);
              asm volatile("" ::: "memory");
            }
        }
    } else if ((EB & 4) && pn < 9) {
      float* base; int ld; float sc = 1.f;
      if (pn == 6) { ld = 128; if (wc < 2) { base = (float*)(ws + OFF_GQ) + wc * 64; sc = 0.17677669529663687f; } else base = (float*)(ws + OFF_GK) + (wc - 2) * 64; }
      else { ld = 256; base = (float*)(ws + (pn == 7 ? OFF_GV : OFF_GR)) + wc * 64; }
#pragma unroll
      for (int ai = 0; ai < 2; ++ai)
#pragma unroll
        for (int m = 0; m < 4; ++m) {
          const int row = rowb + ai * 128 + m * 16;
#pragma unroll
          for (int bj = 0; bj < 2; ++bj)
#pragma unroll
            for (int n = 0; n < 2; ++n) *(f32x4*)(base + (size_t)row * ld + 32 * n + 16 * bj + 4 * fq) = acc[ai][bj][m][n] * sc;
          asm volatile("" ::: "memory");
        }
    } else if (wc == 0) {
      float* base = (float*)(ws + OFF_LR) + 4 * fq;
#pragma unroll
      for (int ai = 0; ai < 2; ++ai)
#pragma unroll
        for (int m = 0; m < 4; ++m) {
          const int row = rowb + ai * 128 + m * 16;
          *(f32x4*)(base + (size_t)row * 32) = acc[ai][0][m][0]; *(f32x4*)(base + (size_t)row * 32 + 16) = acc[ai][0][m][1];
        }
    }
  }
};

template <int NG, bool SHIFT>
DI void attn_tile(const bf16_t* ks, const bf16_t* vs, const bf16x8 (&qf)[NG][4], f32x16 (&o0)[NG], f32x16 (&o1)[NG], float (&lsum)[NG], const f32x16& cinit, int l31, int h) {
  bf16x8 pf[NG][4];
#pragma unroll
  for (int half = 0; half < 2; ++half) {
    f32x16 sv[NG];
#pragma unroll
    for (int s = 0; s < 4; ++s) {
      const bf16x8 a0 = *(const bf16x8*)(ks + (32 * half + l31) * 72 + 16 * s + 8 * h);
#pragma unroll
      for (int g = 0; g < NG; ++g) {
        if (s == 0) {
          if (SHIFT) sv[g] = MFMA32(a0, qf[g][s], cinit);
          else { f32x16 z; for (int i = 0; i < 16; ++i) z[i] = 0.f; sv[g] = MFMA32(a0, qf[g][s], z); }
        } else sv[g] = MFMA32(a0, qf[g][s], sv[g]);
      }
    }
#pragma unroll
    for (int g = 0; g < NG; ++g) {
      float ps = 0.f;
#pragma unroll
      for (int i = 0; i < 16; ++i) { sv[g][i] = __builtin_amdgcn_exp2f(sv[g][i]); ps += sv[g][i]; }
      lsum[g] += ps;
      u32x4 pw;
      pw.x = pk2(sv[g][0], sv[g][1]); pw.y = pk2(sv[g][2], sv[g][3]); pw.z = pk2(sv[g][4], sv[g][5]); pw.w = pk2(sv[g][6], sv[g][7]); pf[g][2 * half] = __builtin_bit_cast(bf16x8, pw);
      pw.x = pk2(sv[g][8], sv[g][9]); pw.y = pk2(sv[g][10], sv[g][11]); pw.z = pk2(sv[g][12], sv[g][13]); pw.w = pk2(sv[g][14], sv[g][15]); pf[g][2 * half + 1] = __builtin_bit_cast(bf16x8, pw);
    }
    asm volatile("" ::: "memory");
  }
#pragma unroll
  for (int kk = 0; kk < 4; ++kk) {
    const int kb = 16 * kk + 4 * h;
    const s16x4 lo0 = *(const s16x4*)(vs + l31 * 68 + kb), hi0 = *(const s16x4*)(vs + l31 * 68 + kb + 8);
    const s16x4 lo1 = *(const s16x4*)(vs + (32 + l31) * 68 + kb), hi1 = *(const s16x4*)(vs + (32 + l31) * 68 + kb + 8);
    const bf16x8 v0 = __builtin_shufflevector(lo0, hi0, 0, 1, 2, 3, 4, 5, 6, 7), v1 = __builtin_shufflevector(lo1, hi1, 0, 1, 2, 3, 4, 5, 6, 7);
#pragma unroll
    for (int g = 0; g < NG; ++g) { o0[g] = MFMA32(v0, pf[g][kk], o0[g]); o1[g] = MFMA32(v1, pf[g][kk], o1[g]); }
  }
}

DI float attn_score_bound(const Params& p, int layer, int lane) {
  float mq = fabsf(p.q_norm_g[layer * 64 + lane]), mk = fabsf(p.k_norm_g[layer * 64 + lane]);
#pragma unroll
  for (int o = 1; o < 64; o <<= 1) { mq = fmaxf(mq, __shfl_xor(mq, o)); mk = fmaxf(mk, __shfl_xor(mk, o)); }
  return (64.f * mq * mk * (0.125f * 1.4426950408889634f)) * 1.001f;
}

template <int NG, bool SHIFT>
DI void attn_unit(const Params& p, unsigned char* lds, int layer, int b, int head, int qrow0, int key0, int nkeys, float cbound, int tid) {
  unsigned char* ws = p.ws;
  const int lane = tid & 63, wave = tid >> 6, l31 = lane & 31, h = lane >> 5, kvh = head >> 2;
  const bf16_t* Kg = (const bf16_t*)(ws + OFF_K) + ((size_t)(b * 2 + kvh) * NKEY + key0) * 64;
  const bf16_t* Vg = (const bf16_t*)(ws + OFF_VT) + ((size_t)(b * 2 + kvh) * 64) * NKEY + key0;
  bf16_t* Ks = (bf16_t*)lds;
  bf16_t* Vs = (bf16_t*)(lds + 18432);
  const int qrowb = qrow0 + wave * (32 * NG) + l31;
  bf16x8 qf[NG][4];
#pragma unroll
  for (int g = 0; g < NG; ++g)
#pragma unroll
    for (int s = 0; s < 4; ++s) qf[g][s] = *(const bf16x8*)((const bf16_t*)(ws + OFF_Q) + (size_t)(qrowb + 32 * g) * 512 + head * 64 + 16 * s + 8 * h);
  f32x16 o0[NG], o1[NG]; float lsum[NG];
#pragma unroll
  for (int g = 0; g < NG; ++g) {
    lsum[g] = 0.f;
#pragma unroll
    for (int i = 0; i < 16; ++i) { o0[g][i] = 0.f; o1[g][i] = 0.f; }
  }
  f32x16 cinit;
#pragma unroll
  for (int i = 0; i < 16; ++i) cinit[i] = SHIFT ? -cbound : 0.f;
  const int ntile = nkeys >> 6, lr = tid >> 3, lc = tid & 7;
#define ATT_LD(kr, vr, t) do { kr = *(const u32x4*)(Kg + (size_t)((t) * 64 + lr) * 64 + lc * 8); vr = *(const u32x4*)(Vg + (size_t)lr * NKEY + (t) * 64 + lc * 8); } while (0)
#define ATT_ST(buf, kr, vr) do { *(u32x4*)(Ks + (buf) * (64 * 72) + lr * 72 + lc * 8) = kr; *(u32x2*)(Vs + (buf) * (64 * 68) + lr * 68 + lc * 8) = (u32x2){vr.x, vr.y}; \
    *(u32x2*)(Vs + (buf) * (64 * 68) + lr * 68 + lc * 8 + 4) = (u32x2){vr.z, vr.w}; } while (0)
#define ATT_BAR() do { asm volatile("s_waitcnt lgkmcnt(0)" ::: "memory"); __builtin_amdgcn_s_barrier(); asm volatile("" ::: "memory"); } while (0)
  u32x4 kr, vr;
  ATT_LD(kr, vr, 0);
  __syncthreads();
  ATT_ST(0, kr, vr);
  if (ntile > 1) ATT_LD(kr, vr, 1);
  ATT_BAR();
#pragma unroll 1
  for (int t = 0; t < ntile; ++t) {
    const int cur = t & 1;
    attn_tile<NG, SHIFT>(Ks + cur * (64 * 72), Vs + cur * (64 * 68), qf, o0, o1, lsum, cinit, l31, h);
    if (t + 1 < ntile) { ATT_ST(cur ^ 1, kr, vr); if (t + 2 < ntile) ATT_LD(kr, vr, t + 2); }
    ATT_BAR();
  }
#undef ATT_LD
#undef ATT_ST
#undef ATT_BAR
  const float* gn = p.out_norm_g + layer * 1024 + head * 64;
#pragma unroll
  for (int g = 0; g < NG; ++g) {
    const float ltot = lsum[g] + __shfl_xor(lsum[g], 32), inv = 1.f / ltot;
    float ss = 0.f;
#pragma unroll
    for (int i = 0; i < 16; ++i) { o0[g][i] *= inv; o1[g][i] *= inv; ss += o0[g][i] * o0[g][i] + o1[g][i] * o1[g][i]; }
    ss += __shfl_xor(ss, 32);
    const float rstd = rsqrtf(ss * (1.f / 64.f) + EPS);
    bf16_t* dst = (bf16_t*)(ws + OFF_U) + (size_t)(qrowb + 32 * g) * 1024 + head * 64;
#pragma unroll
    for (int i4 = 0; i4 < 4; ++i4) {
      const int d = 8 * i4 + 4 * h;
      const f32x4 g0 = *(const f32x4*)(gn + d), g1 = *(const f32x4*)(gn + 32 + d);
      u32x2 w0, w1;
      w0.x = pk2(o0[g][4 * i4] * rstd * g0.x, o0[g][4 * i4 + 1] * rstd * g0.y); w0.y = pk2(o0[g][4 * i4 + 2] * rstd * g0.z, o0[g][4 * i4 + 3] * rstd * g0.w);
      w1.x = pk2(o1[g][4 * i4] * rstd * g1.x, o1[g][4 * i4 + 1] * rstd * g1.y); w1.y = pk2(o1[g][4 * i4 + 2] * rstd * g1.z, o1[g][4 * i4 + 3] * rstd * g1.w);
      *(u32x2*)(dst + d) = w0; *(u32x2*)(dst + 32 + d) = w1;
    }
  }
}

DI float hy_sc(const bf16_t* prow, int t, int n, float w0, float w1, float w2, float bias) {
  const float xm = t > 0 ? bf2f(prow[t - 1]) : 0.f, x0 = bf2f(prow[t]), xp = t + 1 < n ? bf2f(prow[t + 1]) : 0.f;
  return w0 * xm + w1 * x0 + w2 * xp + bias;
}

DI void hyena_lat_item(const Params& p, unsigned char* lds, int layer, int b, int pr, int tid) {
  unsigned char* ws = p.ws;
  float2* buf = (float2*)lds;
  const int ca = 2 * pr;
  const bf16_t* hyp = (const bf16_t*)(ws + OFF_HYP) + (size_t)b * 768 * NKEY;
  const float* cw = p.hy_conv_w + (size_t)layer * 3 * 768; const float* cbias = p.hy_conv_b + (size_t)layer * 768;
  const float* hb = p.hy_bias + (size_t)layer * 512;
  float w[3][2][4];
#pragma unroll
  for (int s = 0; s < 3; ++s)
#pragma unroll
    for (int e = 0; e < 2; ++e) { const int c = s * 256 + ca + e; w[s][e][0] = cw[c]; w[s][e][1] = cw[768 + c]; w[s][e][2] = cw[1536 + c]; w[s][e][3] = cbias[c]; }
  const bf16_t* pv0 = hyp + (size_t)(ca) * NKEY; const bf16_t* pv1 = hyp + (size_t)(ca + 1) * NKEY;
  const bf16_t* p10 = hyp + (size_t)(256 + ca) * NKEY; const bf16_t* p11 = hyp + (size_t)(256 + ca + 1) * NKEY;
  const bf16_t* p20 = hyp + (size_t)(512 + ca) * NKEY; const bf16_t* p21 = hyp + (size_t)(512 + ca + 1) * NKEY;
  float* outa = (float*)(ws + OFF_HYRAW) + ((size_t)b * 256 + ca) * NKEY; float* outb = outa + NKEY;
  const float b0a = hb[ca], b0b = hb[ca + 1], b1a = hb[256 + ca], b1b = hb[256 + ca + 1];
  __syncthreads();
#define HY_FENCE(i) do { if (((i) & 3) == 3) asm volatile("" ::: "memory"); } while (0)
  float2 vv[16];
#pragma unroll
  for (int i = 0; i < 16; ++i) {
    const int t = tid + NT * i;
    vv[i] = make_float2(hy_sc(pv0, t, 8192, w[0][0][0], w[0][0][1], w[0][0][2], w[0][0][3]), hy_sc(pv1, t, 8192, w[0][1][0], w[0][1][1], w[0][1][2], w[0][1][3]));
    buf[t] = vv[i]; buf[8192 + t] = make_float2(0.f, 0.f);
    HY_FENCE(i);
  }
  __syncthreads();
  SpecRegs sr;
  spec_load(sr, (const float4*)(ws + OFF_SPEC) + (size_t)(0 * 128 + pr) * 8193, tid);
  fft_fwd(buf, tid);
  spec_mul(buf, sr, tid);
  float2 xg[16];
#pragma unroll
  for (int i = 0; i < 16; ++i) {
    const int t = tid + NT * i;
    xg[i] = make_float2(hy_sc(p10, t, 8192, w[1][0][0], w[1][0][1], w[1][0][2], w[1][0][3]), hy_sc(p11, t, 8192, w[1][1][0], w[1][1][1], w[1][1][2], w[1][1][3]));
    HY_FENCE(i);
  }
  fft_inv(buf, tid);
#pragma unroll
  for (int i = 0; i < 16; ++i) {
    const int t = tid + NT * i;
    const float2 y = buf[t];
    vv[i] = make_float2(xg[i].x * (y.x * (1.f / 16384.f) + vv[i].x * b0a), xg[i].y * (y.y * (1.f / 16384.f) + vv[i].y * b0b));
    buf[t] = vv[i]; buf[8192 + t] = make_float2(0.f, 0.f);
  }
  __syncthreads();
  spec_load(sr, (const float4*)(ws + OFF_SPEC) + (size_t)(1 * 128 + pr) * 8193, tid);
  fft_fwd(buf, tid);
  spec_mul(buf, sr, tid);
#pragma unroll
  for (int i = 0; i < 16; ++i) {
    const int t = tid + NT * i;
    xg[i] = make_float2(hy_sc(p20, t, 8192, w[2][0][0], w[2][0][1], w[2][0][2], w[2][0][3]), hy_sc(p21, t, 8192, w[2][1][0], w[2][1][1], w[2][1][2], w[2][1][3]));
    HY_FENCE(i);
  }
  fft_inv(buf, tid);
#pragma unroll
  for (int i = 0; i < 16; ++i) {
    const int t = tid + NT * i;
    const float2 y = buf[t];
    outa[t] = xg[i].x * (y.x * (1.f / 16384.f) + vv[i].x * b1a);
    outb[t] = xg[i].y * (y.y * (1.f / 16384.f) + vv[i].y * b1b);
  }
#undef HY_FENCE
  __syncthreads();
}

DI void hyena_ctx_item(const Params& p, unsigned char* lds, int layer, int b, int pr, int tid) {
  unsigned char* ws = p.ws;
  float* lf = (float*)lds;
  const int cs = tid >> 8, t = tid & 255, c = 2 * pr + cs;
  float* vv = lf + cs * 256; float* zz = lf + 512 + cs * 256;
  float* hp0 = lf + 1024 + cs * 256; float* hn0 = lf + 1536 + cs * 256; float* hp1 = lf + 2048 + cs * 256; float* hn1 = lf + 2560 + cs * 256;
  const bf16_t* hyp = (const bf16_t*)(ws + OFF_HYP) + (size_t)b * 768 * NKEY + 8192;
  const float* cw = p.hy_conv_w + (size_t)layer * 3 * 768; const float* cbias = p.hy_conv_b + (size_t)layer * 768;
  const float* hb = p.hy_bias + (size_t)layer * 512;
  const float* hc = (const float*)(ws + OFF_HC) + (size_t)t * 1024;
  const float uv = hy_sc(hyp + (size_t)c * NKEY, t, 256, cw[c], cw[768 + c], cw[1536 + c], cbias[c]);
  const float x1 = hy_sc(hyp + (size_t)(256 + c) * NKEY, t, 256, cw[256 + c], cw[768 + 256 + c], cw[1536 + 256 + c], cbias[256 + c]);
  const float x2 = hy_sc(hyp + (size_t)(512 + c) * NKEY, t, 256, cw[512 + c], cw[768 + 512 + c], cw[1536 + 512 + c], cbias[512 + c]);
  __syncthreads();
  vv[t] = uv; hp0[t] = hc[c]; hn0[t] = hc[256 + c]; hp1[t] = hc[512 + c]; hn1[t] = hc[768 + c];
  __syncthreads();
  float y = 0.f;
  for (int s = 0; s < 256; ++s) y += (s <= t ? hp0[t - s] : hn0[s - t]) * vv[s];
  const float z = x1 * (y + hb[c] * uv);
  zz[t] = z;
  __syncthreads();
  float y2 = 0.f;
  for (int s = 0; s < 256; ++s) y2 += (s <= t ? hp1[t - s] : hn1[s - t]) * zz[s];
  ((float*)(ws + OFF_HYRAW))[((size_t)b * 256 + c) * NKEY + 8192 + t] = x2 * (y2 + hb[256 + c] * z);
  __syncthreads();
}

DI void hyena_norm_item(const Params& p, unsigned char* lds, int layer, int b, int tt, int tid) {
  unsigned char* ws = p.ws;
  float* tile = (float*)lds;
  float* ssb = tile + 256 * 65;
  const int lane = tid & 63, wave = tid >> 6;
  const float* src = (const float*)(ws + OFF_HYRAW) + (size_t)b * 256 * NKEY + tt * 64;
  __syncthreads();
#pragma unroll 4
  for (int i = 0; i < 32; ++i) { const int ch = i * 8 + wave; tile[ch * 65 + lane] = src[(size_t)ch * NKEY + lane]; }
  __syncthreads();
  float v[32]; float ss = 0.f;
#pragma unroll
  for (int j = 0; j < 32; ++j) { v[j] = tile[(wave * 32 + j) * 65 + lane]; ss += v[j] * v[j]; }
  ssb[wave * 64 + lane] = ss;
  __syncthreads();
  const float rstd = rsqrtf((ssb[(wave & ~1) * 64 + lane] + ssb[(wave | 1) * 64 + lane]) * (1.f / 64.f) + EPS);
  const int tok = tt * 64 + lane;
  const int row = tok < 8192 ? b * 8192 + tok : 16384 + b * 256 + (tok - 8192);
  const float* g = p.out_norm_g + layer * 1024 + 512 + wave * 32;
  bf16_t* dst = (bf16_t*)(ws + OFF_U) + (size_t)row * 1024 + 512 + wave * 32;
#pragma unroll
  for (int c8 = 0; c8 < 4; ++c8) {
    u32x4 w;
    w.x = pk2(v[c8 * 8] * rstd * g[c8 * 8], v[c8 * 8 + 1] * rstd * g[c8 * 8 + 1]); w.y = pk2(v[c8 * 8 + 2] * rstd * g[c8 * 8 + 2], v[c8 * 8 + 3] * rstd * g[c8 * 8 + 3]);
    w.z = pk2(v[c8 * 8 + 4] * rstd * g[c8 * 8 + 4], v[c8 * 8 + 5] * rstd * g[c8 * 8 + 5]); w.w = pk2(v[c8 * 8 + 6] * rstd * g[c8 * 8 + 6], v[c8 * 8 + 7] * rstd * g[c8 * 8 + 7]);
    *(u32x4*)(dst + c8 * 8) = w;
  }
}

DI float wave_scan_incl(float x, int lane) {
#pragma unroll
  for (int o = 1; o < 64; o <<= 1) { const float y = __shfl_up(x, o); if (lane >= o) x += y; }
  return x;
}
DI void gla_gates(const Params& p, int layer, const float* lr, int c, float& zf, float& zb) {
  const float* gw = p.gla_gate_w + (size_t)layer * 2 * 16 * 128 + c;
  float a = p.gla_gate_b[layer * 256 + c], b = p.gla_gate_b[layer * 256 + 128 + c];
#pragma unroll
  for (int r4 = 0; r4 < 4; ++r4) {
    const f32x4 lf = *(const f32x4*)(lr + r4 * 4), lb = *(const f32x4*)(lr + 16 + r4 * 4);
    a += lf.x * gw[(r4 * 4) * 128] + lf.y * gw[(r4 * 4 + 1) * 128] + lf.z * gw[(r4 * 4 + 2) * 128] + lf.w * gw[(r4 * 4 + 3) * 128];
    b += lb.x * gw[(16 + r4 * 4) * 128] + lb.y * gw[(16 + r4 * 4 + 1) * 128] + lb.z * gw[(16 + r4 * 4 + 2) * 128] + lb.w * gw[(16 + r4 * 4 + 3) * 128];
  }
  zf = log_sigmoid(a) * 0.0625f; zb = log_sigmoid(b) * 0.0625f;
}

DI int gla_row(int b, int sc, int i) { return sc < 128 ? b * 8192 + sc * 64 + i : 16384 + b * 256 + (sc - 128) * 64 + i; }

DI void gla_local_item(const Params& p, unsigned char* lds, int layer, int b, int sc, int h, int tid) {
  unsigned char* ws = p.ws;
  float* lf = (float*)lds;
  float* kt = lf;
  float* vs = lf + 2 * 64 * 33;
  float* lg = vs + 64 * 68;
  const int row0 = gla_row(b, sc, 0);
  const float* gk = (const float*)(ws + OFF_GK) + (size_t)row0 * 128 + h * 32;
  const float* gv = (const float*)(ws + OFF_GV) + (size_t)row0 * 256 + h * 64;
  const float* lr = (const float*)(ws + OFF_LR) + (size_t)row0 * 32;
  __syncthreads();
  {
    const int d = tid & 31, c = h * 32 + d;
    const float* gw = p.gla_gate_w + (size_t)layer * 2 * 16 * 128 + c;
    float gwf[16], gwb[16];
#pragma unroll
    for (int r = 0; r < 16; ++r) { gwf[r] = gw[r * 128]; gwb[r] = gw[(16 + r) * 128]; }
    const float bf_ = p.gla_gate_b[layer * 256 + c], bb_ = p.gla_gate_b[layer * 256 + 128 + c];
#pragma unroll
    for (int k = 0; k < 4; ++k) {
      const int i = (tid >> 5) + 16 * k;
      const float kk = gk[i * 128 + d]; kt[i * 33 + d] = kk; kt[64 * 33 + i * 33 + d] = kk;
      const f32x4* lp = (const f32x4*)(lr + i * 32);
      float a = bf_, bsum = bb_;
#pragma unroll
      for (int r4 = 0; r4 < 4; ++r4) {
        const f32x4 lf_ = lp[r4], lb_ = lp[4 + r4];
        a += lf_.x * gwf[r4 * 4] + lf_.y * gwf[r4 * 4 + 1] + lf_.z * gwf[r4 * 4 + 2] + lf_.w * gwf[r4 * 4 + 3];
        bsum += lb_.x * gwb[r4 * 4] + lb_.y * gwb[r4 * 4 + 1] + lb_.z * gwb[r4 * 4 + 2] + lb_.w * gwb[r4 * 4 + 3];
      }
      const float zf = log_sigmoid(a) * 0.0625f, zb = log_sigmoid(bsum) * 0.0625f;
      lg[i * 33 + d] = zf; lg[64 * 33 + i * 33 + d] = zb;
      ((float*)(ws + OFF_LGF))[(size_t)(row0 + i) * 128 + c] = zf; ((float*)(ws + OFF_LGB))[(size_t)(row0 + i) * 128 + c] = zb;
    }
  }
  for (int e = tid; e < 4096; e += NT) { const int i = e >> 6, d = e & 63; vs[i * 68 + d] = gv[i * 256 + d]; }
  __syncthreads();
  {
    const int lane = tid & 63, wave = tid >> 6, dir = wave >> 2;
    float* l = lg + dir * 64 * 33; float* k = kt + dir * 64 * 33;
#pragma unroll
    for (int dd = 0; dd < 8; ++dd) {
      const int d = (wave & 3) * 8 + dd;
      const float x = l[lane * 33 + d];
      const float pre = wave_scan_incl(x, lane), tot = __shfl(pre, 63);
      const float cum = dir == 0 ? pre : tot - pre + x;
      k[lane * 33 + d] *= __expf(tot - cum);
      if (lane == 0) ((float*)(ws + OFF_DEC))[(((size_t)(dir * 2 + b) * 4 + h) * 132 + sc) * 32 + d] = __expf(tot);
    }
  }
  __syncthreads();
  {
    const int lane = tid & 63, wave = tid >> 6, fr = lane & 15, fq = lane >> 4;
    const int dir = wave >> 2, tdk = (wave >> 1) & 1, tdv0 = (wave & 1) * 2;
    const float* ka = kt + dir * 64 * 33 + tdk * 16 + fr;
    const float* vb = vs + tdv0 * 16 + fr;
    f32x4 c0 = (f32x4){0.f, 0.f, 0.f, 0.f}, c1 = c0;
#pragma unroll 4
    for (int ks = 0; ks < 16; ++ks) {
      const int j = ks * 4 + fq;
      const float av = ka[j * 33], b0 = vb[j * 68], b1 = vb[j * 68 + 16];
      c0 = MFMA4F(av, b0, c0); c1 = MFMA4F(av, b1, c1);
    }
    float* dst = (float*)(ws + OFF_KV) + ((((size_t)(dir * 2 + b) * 4 + h) * 132 + sc) * 32 + tdk * 16 + fq * 4) * 64 + tdv0 * 16 + fr;
#pragma unroll
    for (int jj = 0; jj < 4; ++jj) { dst[jj * 64] = c0[jj]; dst[jj * 64 + 16] = c1[jj]; }
  }
}

DI void gla_scan(const Params& p, int tid) {
  unsigned char* ws = p.ws;
  for (int blk = bidx(); blk < 64; blk += gdim()) {
    const int chain = blk >> 2, e = (blk & 3) * 512 + tid, dk = e >> 6, dir = chain >> 3;
    float* kv = (float*)(ws + OFF_KV) + (size_t)chain * 132 * 2048 + e;
    const float* dec = (const float*)(ws + OFF_DEC) + (size_t)chain * 132 * 32 + dk;
    float state = 0.f;
#pragma unroll 1
    for (int s0 = 0; s0 < 132; s0 += 12) {
      float kvv[12], dd[12]; int scs[12];
#pragma unroll
      for (int q = 0; q < 12; ++q) {
        const int s = s0 + q;
        const int sc = dir == 0 ? (s < 4 ? 128 + s : s - 4) : 131 - s;
        scs[q] = sc; kvv[q] = kv[(size_t)sc * 2048]; dd[q] = dec[sc * 32];
      }
#pragma unroll
      for (int q = 0; q < 12; ++q) { if (scs[q] < 128) kv[(size_t)scs[q] * 2048] = state; state = dd[q] * state + kvv[q]; }
    }
  }
}

DI void gla_out_item(const Params& p, unsigned char* lds, int layer, int b, int sc, int h, int tid) {
  unsigned char* ws = p.ws;
  float* lf = (float*)lds;
  float* qf = lf;
  float* qb = qf + 64 * 33;
  float* kf = qb + 64 * 33;
  float* kb = kf + 64 * 33;
  float* gf = kb + 64 * 33;
  float* gb = gf + 64 * 33;
  float* vs = gb + 64 * 33;
  float* S = vs + 64 * 68;
  float* spf = S + 64 * 65;
  float* spb = spf + 32 * 68;
  const int row0 = gla_row(b, sc, 0);
  const float* gq = (const float*)(ws + OFF_GQ) + (size_t)row0 * 128 + h * 32;
  const float* gk = (const float*)(ws + OFF_GK) + (size_t)row0 * 128 + h * 32;
  const float* gv = (const float*)(ws + OFF_GV) + (size_t)row0 * 256 + h * 64;
  const float* lr = (const float*)(ws + OFF_LR) + (size_t)row0 * 32;
  const float* pf = (const float*)(ws + OFF_KV) + (((size_t)(0 * 2 + b) * 4 + h) * 132 + sc) * 2048;
  const float* pb = (const float*)(ws + OFF_KV) + (((size_t)(1 * 2 + b) * 4 + h) * 132 + sc) * 2048;
  f32x4 eg0, eg1;
  {
    const int ei = tid >> 3, edv0 = (tid & 7) * 8;
    const float* g = p.out_norm_g + layer * 1024 + 768 + h * 64 + edv0;
    const float* gr = (const float*)(ws + OFF_GR) + (size_t)(row0 + ei) * 256 + h * 64 + edv0;
    const f32x4 g0 = *(const f32x4*)g, g1 = *(const f32x4*)(g + 4), r0 = *(const f32x4*)gr, r1 = *(const f32x4*)(gr + 4);
    eg0 = (f32x4){g0.x * siluf(r0.x), g0.y * siluf(r0.y), g0.z * siluf(r0.z), g0.w * siluf(r0.w)};
    eg1 = (f32x4){g1.x * siluf(r1.x), g1.y * siluf(r1.y), g1.z * siluf(r1.z), g1.w * siluf(r1.w)};
  }
  __syncthreads();
  for (int e = tid; e < 2048; e += NT) {
    const int i = e >> 5, d = e & 31; const float q = gq[i * 128 + d], k = gk[i * 128 + d];
    const float zf = ((const float*)(ws + OFF_LGF))[(size_t)(row0 + i) * 128 + h * 32 + d], zb = ((const float*)(ws + OFF_LGB))[(size_t)(row0 + i) * 128 + h * 32 + d];
    qf[i * 33 + d] = q; qb[i * 33 + d] = q; kf[i * 33 + d] = k; kb[i * 33 + d] = k; gf[i * 33 + d] = zf; gb[i * 33 + d] = zb;
    if (sc < 128) { spf[(e >> 6) * 68 + (e & 63)] = pf[e]; spb[(e >> 6) * 68 + (e & 63)] = pb[e]; }
    else {
      const float* kvf = (const float*)(ws + OFF_KV) + (((size_t)(0 * 2 + b) * 4 + h) * 132) * 2048 + e;
      const float* kvb = (const float*)(ws + OFF_KV) + (((size_t)(1 * 2 + b) * 4 + h) * 132) * 2048 + e;
      const float* dcf = (const float*)(ws + OFF_DEC) + (((size_t)(0 * 2 + b) * 4 + h) * 132) * 32 + (e >> 6);
      const float* dcb = (const float*)(ws + OFF_DEC) + (((size_t)(1 * 2 + b) * 4 + h) * 132) * 32 + (e >> 6);
      float sf = 0.f, sb = 0.f;
      for (int c = 128; c < sc; ++c) sf = dcf[c * 32] * sf + kvf[(size_t)c * 2048];
      for (int c = 131; c > sc; --c) sb = dcb[c * 32] * sb + kvb[(size_t)c * 2048];
      spf[(e >> 6) * 68 + (e & 63)] = sf; spb[(e >> 6) * 68 + (e & 63)] = sb;
    }
  }
  for (int e = tid; e < 4096; e += NT) { const int i = e >> 6, d = e & 63; vs[i * 68 + d] = gv[i * 256 + d]; }
  __syncthreads();
  {
    const int lane = tid & 63, wave = tid >> 6, dir = wave >> 2;
    float* gsrc = dir ? gb : gf; float* qd = dir ? qb : qf; float* kd = dir ? kb : kf;
#pragma unroll
    for (int dd = 0; dd < 8; ++dd) {
      const int d = (wave & 3) * 8 + dd;
      const float x = gsrc[lane * 33 + d];
      const float pre = wave_scan_incl(x, lane), tot = __shfl(pre, 63);
      const float cum = dir == 0 ? pre : tot - pre + x;
      qd[lane * 33 + d] *= __expf(cum); kd[lane * 33 + d] *= __expf(-cum);
    }
  }
  __syncthreads();
  const int lane_ = tid & 63, wave_ = tid >> 6, fr = lane_ & 15, fq = lane_ >> 4, ti = wave_ >> 1, tj0 = (wave_ & 1) * 2;
  {
#pragma unroll
    for (int t = 0; t < 2; ++t) {
      const int tj = tj0 + t;
      f32x4 aF = (f32x4){0.f, 0.f, 0.f, 0.f}, aB = aF;
      if (tj <= ti) {
#pragma unroll
        for (int ks = 0; ks < 8; ++ks) aF = MFMA4F(qf[(ti * 16 + fr) * 33 + ks * 4 + fq], kf[(tj * 16 + fr) * 33 + ks * 4 + fq], aF);
      }
      if (tj >= ti) {
#pragma unroll
        for (int ks = 0; ks < 8; ++ks) aB = MFMA4F(qb[(ti * 16 + fr) * 33 + ks * 4 + fq], kb[(tj * 16 + fr) * 33 + ks * 4 + fq], aB);
      }
#pragma unroll
      for (int jj = 0; jj < 4; ++jj) {
        const int i = ti * 16 + fq * 4 + jj, j = tj * 16 + fr;
        S[i * 65 + j] = (j <= i ? aF[jj] : 0.f) + (j >= i ? aB[jj] : 0.f);
      }
    }
  }
  __syncthreads();
  {
    f32x4 c0 = (f32x4){0.f, 0.f, 0.f, 0.f}, c1 = c0;
    const float* vb = vs + tj0 * 16 + fr; const float* fb = spf + tj0 * 16 + fr; const float* bb = spb + tj0 * 16 + fr;
#pragma unroll 4
    for (int ks = 0; ks < 16; ++ks) {
      const int k = ks * 4 + fq; const float av = S[(ti * 16 + fr) * 65 + k];
      c0 = MFMA4F(av, vb[k * 68], c0); c1 = MFMA4F(av, vb[k * 68 + 16], c1);
    }
#pragma unroll 4
    for (int ks = 0; ks < 8; ++ks) {
      const int k = ks * 4 + fq; const float a1 = qf[(ti * 16 + fr) * 33 + k], a2 = qb[(ti * 16 + fr) * 33 + k];
      c0 = MFMA4F(a1, fb[k * 68], c0); c1 = MFMA4F(a1, fb[k * 68 + 16], c1);
      c0 = MFMA4F(a2, bb[k * 68], c0); c1 = MFMA4F(a2, bb[k * 68 + 16], c1);
    }
    __syncthreads();
#pragma unroll
    for (int jj = 0; jj < 4; ++jj) { float* sp = S + (ti * 16 + fq * 4 + jj) * 65 + tj0 * 16 + fr; sp[0] = c0[jj]; sp[16] = c1[jj]; }
  }
  __syncthreads();
  {
    const int i = tid >> 3, dv0 = (tid & 7) * 8;
    float acc[8];
#pragma unroll
    for (int e = 0; e < 8; ++e) acc[e] = S[i * 65 + dv0 + e];
    float ss = 0.f;
#pragma unroll
    for (int e = 0; e < 8; ++e) ss += acc[e] * acc[e];
    ss += __shfl_xor(ss, 1); ss += __shfl_xor(ss, 2); ss += __shfl_xor(ss, 4);
    const float rstd = rsqrtf(ss * (1.f / 64.f) + EPS);
    const int row = row0 + i;
    float o[8];
    o[0] = acc[0] * rstd * eg0.x; o[1] = acc[1] * rstd * eg0.y; o[2] = acc[2] * rstd * eg0.z; o[3] = acc[3] * rstd * eg0.w;
    o[4] = acc[4] * rstd * eg1.x; o[5] = acc[5] * rstd * eg1.y; o[6] = acc[6] * rstd * eg1.z; o[7] = acc[7] * rstd * eg1.w;
    u32x4 w; w.x = pk2(o[0], o[1]); w.y = pk2(o[2], o[3]); w.z = pk2(o[4], o[5]); w.w = pk2(o[6], o[7]);
    *(u32x4*)((bf16_t*)(ws + OFF_U) + (size_t)row * 1024 + 768 + h * 64 + dv0) = w;
  }
}

DI void p3_run(const Params& p, unsigned char* lds, int layer, int* cnt, int tid_in, int* s_item_p) {
  for (;;) {
    int tid = tid_in; asm volatile("" : "+v"(tid));
    __syncthreads();
    if (tid == 0) *s_item_p = atomicAdd(cnt, 1);
    __syncthreads();
    const int it = *s_item_p;
    if (it >= 1840) break;
    if (layer == 3 && it >= 512 && it < 784) continue;
    if (it < 256) {
      const int b = it >> 7, r = it & 127, hd = r >> 4, q0 = b * 8192 + (r & 15) * 512;
      const float cb = attn_score_bound(p, layer, tid & 63);
      if (cb < 64.f) attn_unit<2, false>(p, lds, layer, b, hd, q0, 0, NKEY, cb, tid);
      else { attn_unit<1, true>(p, lds, layer, b, hd, q0, 0, NKEY, cb, tid); attn_unit<1, true>(p, lds, layer, b, hd, q0 + 256, 0, NKEY, cb, tid); }
    }
    else if (it < 512) { const int i = it - 256; hyena_lat_item(p, lds, layer, i >> 7, i & 127, tid); }
    else if (it < 528) { const int i = it - 512, b = i >> 3; attn_unit<1, true>(p, lds, layer, b, i & 7, 16384 + b * 256, 8192, 256, attn_score_bound(p, layer, tid & 63), tid); }
    else if (it < 784) { const int i = it - 528; hyena_ctx_item(p, lds, layer, i >> 7, i & 127, tid); }
    else { const int i = it - 784, b = i / 528, r = i % 528; gla_local_item(p, lds, layer, b, r >> 2, r & 3, tid); }
  }
}

__global__ void __launch_bounds__(NT) mk_fwd(Params p_arg) {
  extern __shared__ __attribute__((aligned(16))) unsigned char lds[];
  __shared__ __attribute__((aligned(16))) int s_misc[4];
  int& s_item = s_misc[0];
  cg::grid_group grid = cg::this_grid();
  int tid = threadIdx.x;
  if (tid < 4) s_misc[tid] = 0;
  __syncthreads();
  typedef const __attribute__((address_space(4))) Params* KP;
#if defined(__HIP_DEVICE_COMPILE__)
  const KP kp = (KP)__builtin_amdgcn_kernarg_segment_ptr();
  unsigned char* ws = kp->ws;
#else
  unsigned char* ws = p_arg.ws;
#endif
#define OPQ() asm volatile("" : "+v"(tid))
#ifdef PROF_A
  unsigned long long t_prev = 0; unsigned long long* tacc = (unsigned long long*)(ws + OFF_CNT + 1024);
  if (blockIdx.x == 0 && threadIdx.x == 0) { for (int i = 0; i < 16; ++i) tacc[i] = 0ull; t_prev = wall_clock64(); }
#define STAMP(k) do { if (blockIdx.x == 0 && threadIdx.x == 0) { const unsigned long long t_ = wall_clock64(); tacc[k] += t_ - t_prev; t_prev = t_; } } while (0)
#else
#define STAMP(k) do {} while (0)
#endif
#if defined(__HIP_DEVICE_COMPILE__)
#define LOADP() KP kq_ = kp; asm volatile("" : "+s"(kq_)); Params p; p.x = kq_->x; p.c = kq_->c; p.ctx = kq_->ctx; p.c_ctx = kq_->c_ctx; p.ada_w = kq_->ada_w; p.ada_b = kq_->ada_b; p.norm1_g = kq_->norm1_g; p.w_in = kq_->w_in; p.q_norm_g = kq_->q_norm_g; p.k_norm_g = kq_->k_norm_g; p.hy_conv_w = kq_->hy_conv_w; p.hy_conv_b = kq_->hy_conv_b; p.filt_w1 = kq_->filt_w1; p.filt_b1 = kq_->filt_b1; p.filt_w2 = kq_->filt_w2; p.filt_b2 = kq_->filt_b2; p.filt_w3 = kq_->filt_w3; p.filt_freq = kq_->filt_freq; p.hy_bias = kq_->hy_bias; p.gla_gate_w = kq_->gla_gate_w; p.gla_gate_b = kq_->gla_gate_b; p.out_norm_g = kq_->out_norm_g; p.w_out = kq_->w_out; p.norm2_g = kq_->norm2_g; p.ffn_w1 = kq_->ffn_w1; p.ffn_w3 = kq_->ffn_w3; p.ffn_w2 = kq_->ffn_w2; p.final_norm_g = kq_->final_norm_g; p.out = kq_->out; p.ws = kq_->ws; unsigned char* ws = p.ws; (void)ws;
#else
#define LOADP() Params p = p_arg; unsigned char* ws = p.ws; (void)ws
#endif
  { LOADP(); if (PH & 1) phase0(p, lds, tid); }
  grid.sync(); STAMP(0);
  XcdBarrier xbar = xcd_barrier_post((unsigned*)(ws + OFF_BAR), (volatile XLAS unsigned*)(s_misc + 2));
  for (int layer = 0; layer < 4; ++layer) {
    OPQ();
    { LOADP(); if (PH & 2) spectra_items(p, layer, lds, tid); }
    OPQ();
    { LOADP(); if (PH & 4) ctx_filters(p, layer, tid); }
    OPQ();
    { LOADP(); if (PH & 8) weight_prep(p, layer, lds, tid); }
    OPQ();
    { LOADP(); if (PH & 16) norm_rows(p, layer, 0, tid); }
    xcd_barrier(xbar); STAMP(1);
    OPQ();
    {
      LOADP();
      pg8::Gemm g{(const bf16_t*)(ws + OFF_U), (const bf16_t*)(ws + OFF_WIN), TOK, 2560, 1024}; pg8::StaticOrder S; S.init(TOK, 2560, gdim(), bidx());
      EpiInproj E{ws, p.q_norm_g + layer * 64, p.k_norm_g + layer * 64};
      if (PH & 32) pg8::gemm_phase<EpiInproj, pg8::StaticOrder, true, true>((PG8_LAS unsigned char*)lds, g, S, E, tid);
    }
    xcd_barrier(xbar); STAMP(2);
    OPQ();
    { int nrep = REP3; asm volatile("" : "+s"(nrep));
#pragma unroll 1
      for (int rep = 0; rep < nrep; ++rep) { OPQ(); LOADP(); p3_run(p, lds, layer, (int*)(ws + OFF_CNT) + layer + 8 * rep, tid, &s_item); } }
    xcd_barrier(xbar); STAMP(3);
    OPQ();
    { LOADP(); if (PH & 128) gla_scan(p, tid); }
    OPQ();
    { LOADP(); if (PH & 256) for (int it = bidx(); it < 264; it += gdim()) hyena_norm_item(p, lds, layer, it / 132, it % 132, tid); }
    OPQ();
    { LOADP(); if (layer < 3) for (int j = bidx() - 64; j >= 0 && j < 32; j += gdim()) gla_out_item(p, lds, layer, j >> 4, 128 + ((j >> 2) & 3), j & 3, tid); }
    xcd_barrier(xbar); STAMP(4);
    OPQ();
    { LOADP(); if (PH & 512) for (int it = bidx(); it < 1024; it += gdim()) gla_out_item(p, lds, layer, it >> 9, (it & 511) >> 2, it & 3, tid); }
    xcd_barrier(xbar); STAMP(5);
    OPQ();
    {
      pg8::Gemm g{(const bf16_t*)(ws + OFF_U), (const bf16_t*)(ws + OFF_WOUT), 16384, 1024, 1024}; pg8::StaticOrder S; S.init(16384, 1024, gdim(), bidx());
      EpiResid E{(float*)(ws + OFF_HRES), (const float*)(ws + OFF_MOD) + layer * 3 * 6144, 2048};
      if (PH & 1024) pg8::gemm_phase<EpiResid, pg8::StaticOrder, true, true>((PG8_LAS unsigned char*)lds, g, S, E, tid);
      OPQ();
      if (PH & 4096) if (layer < 3) { LOADP(); gemm_ctx(p, lds, (const bf16_t*)(ws + OFF_U), (const bf16_t*)(ws + OFF_WOUT), 1024, tid); }
    }
    xcd_barrier(xbar); STAMP(6);
    OPQ();
    { LOADP(); if (PH & 16) norm_rows(p, layer, 1, tid); }
    xcd_barrier(xbar); STAMP(7);
    OPQ();
    {
      const int Mr = layer < 3 ? TOK : 16384;
      pg8::Gemm g{(const bf16_t*)(ws + OFF_U), (const bf16_t*)(ws + OFF_W13), Mr, 5632, 1024}; pg8::StaticOrder S; S.init(Mr, 5632, gdim(), bidx());
      EpiSwiglu E{(bf16_t*)(ws + OFF_HMID)};
      if (PH & 2048) pg8::gemm_phase<EpiSwiglu, pg8::StaticOrder, true, true>((PG8_LAS unsigned char*)lds, g, S, E, tid);
    }
    xcd_barrier(xbar); STAMP(8);
    OPQ();
    {
      pg8::Gemm g{(const bf16_t*)(ws + OFF_HMID), (const bf16_t*)(ws + OFF_W2), 16384, 1024, 2816}; pg8::StaticOrder S; S.init(16384, 1024, gdim(), bidx());
      EpiResid E{(float*)(ws + OFF_HRES), (const float*)(ws + OFF_MOD) + layer * 3 * 6144, 5120};
      if (PH & 8192) pg8::gemm_phase<EpiResid, pg8::StaticOrder, true, true>((PG8_LAS unsigned char*)lds, g, S, E, tid);
      OPQ();
      if (PH & 4096) if (layer < 3) { LOADP(); gemm_ctx(p, lds, (const bf16_t*)(ws + OFF_HMID), (const bf16_t*)(ws + OFF_W2), 2816, tid); }
    }
    xcd_barrier(xbar); STAMP(9);
  }
  OPQ();
  {
    LOADP();
    const int lane = tid & 63, gw = bidx() * 8 + (tid >> 6), nw = gdim() * 8;
    const float* hres = (const float*)(ws + OFF_HRES);
    for (int row = gw; row < 16384; row += nw) {
      const f32x4* xr = (const f32x4*)(hres + (size_t)row * 1024) + lane;
      f32x4 v[4]; float s = 0.f;
#pragma unroll
      for (int j = 0; j < 4; ++j) { v[j] = xr[64 * j]; s += v[j].x * v[j].x + v[j].y * v[j].y + v[j].z * v[j].z + v[j].w * v[j].w; }
      const float rstd = rsqrtf(wave_sum(s) * (1.f / 1024.f) + EPS);
#pragma unroll
      for (int j = 0; j < 4; ++j) {
        const int col = lane * 4 + 256 * j;
        *(f32x4*)(p.out + (size_t)row * 1024 + col) = v[j] * rstd * *(const f32x4*)(p.final_norm_g + col);
      }
    }
  }
#ifdef PROF_A
  if (blockIdx.x == 0 && threadIdx.x == 0) {
    const unsigned long long want = tacc[PROF_A], t0 = wall_clock64();
    while (wall_clock64() - t0 < want) __builtin_amdgcn_s_sleep(8);
  }
#endif
}

extern "C" void kernel_launch(void* const* d_in, const int* in_sizes, int n_in, void* d_out, int out_size, void* d_ws, size_t ws_size, hipStream_t stream) {
  static int grid_blocks = 0;
  if (!grid_blocks) {
    int dev = 0, cus = 0, per_cu = 0;
    hipGetDevice(&dev);
    hipDeviceGetAttribute(&cus, hipDeviceAttributeMultiprocessorCount, dev);
    hipFuncSetAttribute((const void*)mk_fwd, hipFuncAttributeMaxDynamicSharedMemorySize, LDS_BYTES);
    hipOccupancyMaxActiveBlocksPerMultiprocessor(&per_cu, (const void*)mk_fwd, NT, LDS_BYTES);
    if (per_cu < 1) per_cu = 1;
    grid_blocks = cus * per_cu;
    if (ws_size < WS_NEED || n_in != 28) { fprintf(stderr, "kernel_launch: ws_size %zu < %llu or n_in %d != 28\n", ws_size, (unsigned long long)WS_NEED, n_in); grid_blocks = -1; }
  }
  if (grid_blocks < 0) return;
  Params p{};
  const float** pp = (const float**)&p;
  for (int i = 0; i < 28; ++i) pp[i] = (const float*)d_in[i];
  p.out = (float*)d_out; p.ws = (unsigned char*)d_ws;
  void* args[] = {&p};
  hipError_t e = hipLaunchCooperativeKernel((const void*)mk_fwd, dim3(grid_blocks), dim3(NT), args, LDS_BYTES, stream);
  if (e != hipSuccess) fprintf(stderr, "cooperative launch failed: %s (grid %d)\n", hipGetErrorString(e), grid_blocks);
}
```
